# Optimizing an MI355X kernel written in HIP

```python
import math
import jax, jax.numpy as jnp
from jax import lax
import numpy as np

D_MODEL = 2048
BATCH = 16
SEQ = 2048
DEPTH = 4

F32 = jnp.float32
N_MEM = 256
Q_BLOCK = 128
DIFF_HEADS = D_MODEL // 256
DIFF_DQK = 32
DIFF_DV = 2 * DIFF_DQK
SWA_HEADS = D_MODEL // 128
SWA_KV_HEADS = 2
SWA_DH = 64
SWA_WINDOW = 128
GLA_HEADS = D_MODEL // 512
GLA_DK = 64
GLA_DV = 128
GLA_RANK = 16
GLA_TAU = 16.0
GLA_CHUNK = 64
D_DIFF = DIFF_HEADS * DIFF_DV
D_SWA = SWA_HEADS * SWA_DH
D_GLA = GLA_HEADS * GLA_DV
D_MIX = D_DIFF + D_SWA + D_GLA
IN_WIDTHS = (
    DIFF_HEADS * 2 * DIFF_DQK,
    DIFF_HEADS * 2 * DIFF_DQK,
    D_DIFF,
    D_SWA,
    SWA_KV_HEADS * SWA_DH,
    SWA_KV_HEADS * SWA_DH,
    GLA_HEADS * GLA_DK,
    GLA_HEADS * GLA_DK,
    D_GLA,
    GLA_RANK,
    D_GLA,
)
D_IN = sum(IN_WIDTHS)
SPLIT_POINTS = [int(v) for v in np.cumsum(IN_WIDTHS)[:-1]]
XA_HEADS = 4
XA_DH = 128
D_XA = XA_HEADS * XA_DH
D_FF = int(math.ceil(8 * D_MODEL / 3 / 256)) * 256
CONV_W = 3
EPS = 1e-6

kernel_name = "hybrid_diff_swa_gla_trunk"


def rmsnorm(x, g):
    xf = x.astype(F32)
    y = xf * lax.rsqrt(jnp.mean(xf * xf, axis=-1, keepdims=True) + EPS)
    return (y * g.astype(F32)).astype(x.dtype)


def alibi_slopes(n):
    return 2.0 ** (-8.0 * jnp.arange(1, n + 1, dtype=F32) / n)


def diff_attention(q, k, v, lam, subln_g, lambda_init):
    B, S, H, _, dq = q.shape
    dv = v.shape[-1]
    nb = S // Q_BLOCK
    scale = dq ** -0.5
    slopes = alibi_slopes(H)
    lamf = lam.astype(F32)
    lam_full = jnp.exp(jnp.sum(lamf[0] * lamf[1])) - jnp.exp(jnp.sum(lamf[2] * lamf[3])) + lambda_init
    pos_k = jnp.arange(S)
    qb = q.reshape(B, nb, Q_BLOCK, H, 2, dq).transpose(1, 0, 2, 3, 4, 5)

    def block(args):
        qi, n = args
        pos_q = n * Q_BLOCK + jnp.arange(Q_BLOCK)
        dist = pos_q[:, None] - pos_k[None, :]
        s = jnp.einsum('bqhcd,bkhcd->bhcqk', qi, k).astype(F32) * scale
        s = s - slopes[None, :, None, None, None] * dist.astype(F32)
        s = jnp.where(dist >= 0, s, -jnp.inf)
        p = jax.nn.softmax(s, axis=-1)
        a = p[:, :, 0] - lam_full * p[:, :, 1]
        return jnp.einsum('bhqk,bkhd->bqhd', a.astype(v.dtype), v)

    o = lax.map(block, (qb, jnp.arange(nb)))
    o = o.transpose(1, 0, 2, 3, 4).reshape(B, S, H, dv)
    o = rmsnorm(o, subln_g) * (1.0 - lambda_init)
    return o.reshape(B, S, H * dv)


def swa_attention(q, k, v, sinks):
    B, S, Hq, dh = q.shape
    G = k.shape[2]
    R = Hq // G
    W = SWA_WINDOW
    nb = S // W
    slopes = alibi_slopes(Hq).reshape(G, R)
    qb = q.reshape(B, nb, W, G, R, dh)

    def with_prev(t):
        tb = t.reshape(B, nb, W, G, dh)
        prev = jnp.concatenate([jnp.zeros_like(tb[:, :1]), tb[:, :-1]], axis=1)
        return jnp.concatenate([prev, tb], axis=2)

    kw, vw = with_prev(k), with_prev(v)
    s = jnp.einsum('bnqgrd,bnkgd->bngrqk', qb, kw).astype(F32) * (dh ** -0.5)
    i = jnp.arange(W)[:, None]
    j = jnp.arange(2 * W)[None, :]
    dist = i + W - j
    blk = jnp.arange(nb)[:, None, None]
    valid = (dist >= 0) & (dist < W) & (blk * W - W + j[None] >= 0)
    s = s - slopes[:, :, None, None] * dist.astype(F32)
    s = jnp.where(valid[None, :, None, None], s, -jnp.inf)
    sink = jnp.broadcast_to(sinks.astype(F32).reshape(G, R)[None, None, :, :, None, None], s.shape[:-1] + (1,))
    p = jax.nn.softmax(jnp.concatenate([s, sink], axis=-1), axis=-1)[..., :-1]
    o = jnp.einsum('bngrqk,bnkgd->bnqgrd', p.astype(v.dtype), vw)
    return o.reshape(B, S, Hq * dh)


def gla_attention(q, k, v, log_a):
    B, S, H, dk = q.shape
    dv = v.shape[-1]
    C = GLA_CHUNK
    nc = S // C

    def chunk(t):
        return t.astype(F32).reshape(B, nc, C, H, t.shape[-1])

    qc = chunk(q) * (dk ** -0.5)
    kc, vc, gc = chunk(k), chunk(v), chunk(log_a)
    b = jnp.cumsum(gc, axis=2)
    b_last = b[:, :, -1:]
    q_dec = qc * jnp.exp(b)
    k_inv = kc * jnp.exp(-b)
    k_end = kc * jnp.exp(b_last - b)
    causal = jnp.tril(jnp.ones((C, C), dtype=bool))
    attn = jnp.where(causal, jnp.einsum('bnthd,bnshd->bnhts', q_dec, k_inv), 0.0)
    o_intra = jnp.einsum('bnhts,bnshv->bnthv', attn, vc)
    kv = jnp.einsum('bnshd,bnshv->bnhdv', k_end, vc)
    decay = jnp.exp(b_last[:, :, 0])

    def step(state, inp):
        kv_n, dec_n = inp
        return state * dec_n[..., None] + kv_n, state

    init = jnp.zeros((B, H, dk, dv), F32)
    _, states = lax.scan(step, init, (kv.transpose(1, 0, 2, 3, 4), decay.transpose(1, 0, 2, 3)))
    states = states.transpose(1, 0, 2, 3, 4)
    o_inter = jnp.einsum('bnthd,bnhdv->bnthv', q_dec, states)
    return (o_intra + o_inter).reshape(B, S, H, dv)


def cross_attention(xn, memn, wq, wkv, wo):
    B, S, _ = xn.shape
    M = memn.shape[1]
    q = (xn @ wq).reshape(B, S, XA_HEADS, XA_DH)
    k, v = jnp.split(memn @ wkv, 2, axis=-1)
    k = k.reshape(B, M, XA_HEADS, XA_DH)
    v = v.reshape(B, M, XA_HEADS, XA_DH)
    s = jnp.einsum('bshd,bmhd->bhsm', q, k).astype(F32) * (XA_DH ** -0.5)
    p = jax.nn.softmax(s, axis=-1)
    o = jnp.einsum('bhsm,bmhd->bshd', p.astype(v.dtype), v).reshape(B, S, D_XA)
    return o @ wo


def conv_glu(xn, w_up, conv_w, conv_b, w_down):
    h = xn @ w_up
    hp = jnp.pad(h, ((0, 0), (CONV_W - 1, 0), (0, 0)))
    h = hp[:, :-2] * conv_w[0] + hp[:, 1:-1] * conv_w[1] + hp[:, 2:] * conv_w[2] + conv_b
    gate, up = jnp.split(h, 2, axis=-1)
    return (jax.nn.silu(gate) * up) @ w_down


def setup_inputs(seed: int = 0) -> dict:
    key = jax.random.key(seed)
    ks = jax.random.split(key, 24)
    L, D = DEPTH, D_MODEL

    def nrm(k, shape, scale):
        return jax.random.normal(k, shape, F32) * scale

    def gain(k, shape):
        return 1.0 + 0.02 * jax.random.normal(k, shape, F32)

    return {
        "x": nrm(ks[0], (BATCH, SEQ, D), 1.0),
        "mem": nrm(ks[1], (BATCH, N_MEM, D), 1.0),
        "norm_mix_g": gain(ks[2], (L, D)),
        "w_in": nrm(ks[3], (L, D, D_IN), D ** -0.5),
        "diff_lambda": nrm(ks[4], (L, 4, DIFF_DQK), 0.1),
        "diff_subln_g": gain(ks[5], (L, DIFF_DV)),
        "swa_sinks": nrm(ks[6], (L, SWA_HEADS), 1.0),
        "gla_gate_w2": nrm(ks[7], (L, GLA_RANK, GLA_HEADS * GLA_DK), GLA_RANK ** -0.5),
        "gla_gate_b": nrm(ks[8], (L, GLA_HEADS * GLA_DK), 0.02),
        "gla_norm_g": gain(ks[9], (L, GLA_DV)),
        "w_out": nrm(ks[10], (L, D_MIX, D), D_MIX ** -0.5),
        "norm_xa_g": gain(ks[11], (L, D)),
        "norm_mem_g": gain(ks[12], (L, D)),
        "xa_wq": nrm(ks[13], (L, D, D_XA), D ** -0.5),
        "xa_wkv": nrm(ks[14], (L, D, 2 * D_XA), D ** -0.5),
        "xa_wo": nrm(ks[15], (L, D_XA, D), D_XA ** -0.5),
        "norm_ffn_g": gain(ks[16], (L, D)),
        "ffn_w_up": nrm(ks[17], (L, D, 2 * D_FF), D ** -0.5),
        "ffn_conv_w": nrm(ks[18], (L, CONV_W, 2 * D_FF), CONV_W ** -0.5),
        "ffn_conv_b": nrm(ks[19], (L, 2 * D_FF), 0.02),
        "ffn_w_down": nrm(ks[20], (L, D_FF, D), D_FF ** -0.5),
        "final_norm_g": gain(ks[21], (D,)),
    }


def reference(x, mem, norm_mix_g, w_in, diff_lambda, diff_subln_g, swa_sinks, gla_gate_w2, gla_gate_b, gla_norm_g, w_out, norm_xa_g, norm_mem_g, xa_wq, xa_wkv, xa_wo, norm_ffn_g, ffn_w_up, ffn_conv_w, ffn_conv_b, ffn_w_down, final_norm_g):
    B, S, _ = x.shape
    h = x
    for l in range(DEPTH):
        xn = rmsnorm(h, norm_mix_g[l])
        (d_q, d_k, d_v, s_q, s_k, s_v, g_q, g_k, g_v, g_lr, g_og) = jnp.split(xn @ w_in[l], SPLIT_POINTS, axis=-1)
        lambda_init = 0.8 - 0.6 * math.exp(-0.3 * l)
        y_diff = diff_attention(
            d_q.reshape(B, S, DIFF_HEADS, 2, DIFF_DQK),
            d_k.reshape(B, S, DIFF_HEADS, 2, DIFF_DQK),
            d_v.reshape(B, S, DIFF_HEADS, DIFF_DV),
            diff_lambda[l], diff_subln_g[l], lambda_init)
        y_swa = swa_attention(
            s_q.reshape(B, S, SWA_HEADS, SWA_DH),
            s_k.reshape(B, S, SWA_KV_HEADS, SWA_DH),
            s_v.reshape(B, S, SWA_KV_HEADS, SWA_DH),
            swa_sinks[l])
        z = (g_lr @ gla_gate_w2[l] + gla_gate_b[l]).astype(F32)
        log_a = (jax.nn.log_sigmoid(z) / GLA_TAU).reshape(B, S, GLA_HEADS, GLA_DK)
        o_gla = gla_attention(
            g_q.reshape(B, S, GLA_HEADS, GLA_DK),
            g_k.reshape(B, S, GLA_HEADS, GLA_DK),
            g_v.reshape(B, S, GLA_HEADS, GLA_DV),
            log_a)
        y_gla = (rmsnorm(o_gla, gla_norm_g[l]).reshape(B, S, D_GLA) * jax.nn.silu(g_og.astype(F32))).astype(x.dtype)
        mix = jnp.concatenate([y_diff.astype(x.dtype), y_swa.astype(x.dtype), y_gla], axis=-1)
        h = h + mix @ w_out[l]
        h = h + cross_attention(rmsnorm(h, norm_xa_g[l]), rmsnorm(mem, norm_mem_g[l]), xa_wq[l], xa_wkv[l], xa_wo[l])
        h = h + conv_glu(rmsnorm(h, norm_ffn_g[l]), ffn_w_up[l], ffn_conv_w[l], ffn_conv_b[l], ffn_w_down[l])
    return rmsnorm(h, final_norm_g)
```

```cpp
#include <hip/hip_runtime.h>
#include <cstdio>
#include <cstdint>
namespace pg8 {
#define PG8_LAS __attribute__((address_space(3)))
typedef unsigned short bf16_t;
typedef short bf16x8 __attribute__((ext_vector_type(8)));
typedef float f32x4 __attribute__((ext_vector_type(4)));
typedef unsigned u32x4 __attribute__((ext_vector_type(4)));
constexpr int BM = 256, BK = 64, HALF = 128, HTB = HALF * BK * 2  , STAGE_BYTES = 8 * HTB, NXCD = 8, WGM = 8;

__host__ __device__ __forceinline__ int lds_byte(int r, int c) { const int st = (r >> 4) * 2 + (c >> 5), rr = r & 15, cc = c & 31, ob = rr * 64 + cc * 2; return st * 1024 + (ob ^ (((ob >> 9) & 1) << 5)); }
__host__ __device__ __forceinline__ void stage_rc(int b, int& R, int& C) { const int st = b / 1024, sb = b % 1024, swz = sb ^ (((sb >> 9) & 1) << 5); R = (st >> 1) * 16 + swz / 64; C = (st & 1) * 32 + (swz % 64) / 2; }
__host__ __device__ __forceinline__ int perm32(int rho) { const int n = rho >> 4, i = rho & 15; return 8 * (i >> 2) + 4 * n + (i & 3); }

struct Unit { int pm, pn; };
struct Gemm { const bf16_t* A; const bf16_t* Bt; int M, N, K; };

struct StaticOrder {
    int nM, nN, nwg, G, c;
    __host__ __device__ void init(int M, int N, int G_, int c_) { nM = M / BM; nN = N / BM; nwg = nM * nN; G = G_; c = c_; }
    __host__ __device__ bool next(int i, Unit& u) const {
        const long L = (long)i * G + c; if (L >= nwg) return false;
        int wgid = (int)L; { const int q = nwg / NXCD, r = nwg % NXCD, xcd = wgid % NXCD, off = wgid / NXCD; wgid = (xcd < r ? xcd * (q + 1) : r * (q + 1) + (xcd - r) * q) + off; }
        const int nig = WGM * nN, gid = wgid / nig, fm = gid * WGM, gsz = (nM - fm) < WGM ? (nM - fm) : WGM;
        u.pm = fm + ((wgid % nig) % gsz); u.pn = (wgid % nig) / gsz; return true;
    }
    __device__ __forceinline__ void a_ready(const Unit&) const {}
    __device__ __forceinline__ void done(const Unit&) const {}
};

typedef float f32x2c_t __attribute__((ext_vector_type(2))); typedef __bf16 bf16x2c_t __attribute__((ext_vector_type(2)));
__device__ __forceinline__ unsigned cvt_pk_bf16(float lo, float hi) { f32x2c_t v = {lo, hi}; bf16x2c_t b = __builtin_convertvector(v, bf16x2c_t); return __builtin_bit_cast(unsigned, b); }
template <class Epi, class Sched, bool ALIGN_EPI = false, bool SP2 = false>
__device__ __forceinline__ void gemm_phase(PG8_LAS unsigned char* lds, const Gemm g, const Sched& S, const Epi& E) {
    int tid_ = threadIdx.x; asm volatile("" : "+v"(tid_));
    const int tid = tid_, wid = __builtin_amdgcn_readfirstlane(tid >> 6), lane = tid & 63, wr = wid >> 2, wc = wid & 3, fr = lane & 15, fq = lane >> 4;
    const int K = g.K, nt = K / BK;
    unsigned voffA[2], voffB[2];
#pragma unroll
    for (int i = 0; i < 2; ++i) { int R, C; stage_rc(tid * 16 + i * 8192, R, C); const int Rb = Epi::PERM ? ((R & ~31) + perm32(R & 31)) : R;
        voffA[i] = (unsigned)(R * K + C) * 2u; voffB[i] = (unsigned)(Rb * K + C) * 2u; }
    const size_t kstep = (size_t)(BK * 2);
    const size_t hstep = (size_t)HALF * K * 2;
    const size_t tstep = 2 * hstep;
    const unsigned ldsw = (unsigned)wid * 1024u;
    const int aoff = lds_byte(wr * 64 + fr, fq * 8), boff = lds_byte(wc * 32 + fr, fq * 8);
#define PG8_SA(b, h) (((b) * 2 + (h)) * HTB)
#define PG8_SB(b, h) ((4 + (b) * 2 + (h)) * HTB)
#define PG8_STAGE(bufoff, gbase, voff) do { _Pragma("unroll") for (int _i = 0; _i < 2; ++_i) \
        __builtin_amdgcn_global_load_lds((const unsigned*)((const char*)(gbase) + (voff)[_i]), (PG8_LAS unsigned*)(lds + (bufoff) + ldsw + _i * 8192), 16, 0, 0); } while (0)
#define PG8_LDA(dst, b, h) do { _Pragma("unroll") for (int m = 0; m < 4; ++m) _Pragma("unroll") for (int k = 0; k < 2; ++k) dst[m][k] = *(const PG8_LAS bf16x8*)(lds + PG8_SA(b, h) + aoff + m * 2048 + k * 1024); } while (0)
#define PG8_LDB(dst, b, h) do { _Pragma("unroll") for (int n = 0; n < 2; ++n) _Pragma("unroll") for (int k = 0; k < 2; ++k) dst[n][k] = *(const PG8_LAS bf16x8*)(lds + PG8_SB(b, h) + boff + n * 2048 + k * 1024); } while (0)
#define PG8_MMA(ai, bj, At, Bt) do { __builtin_amdgcn_s_setprio(1); _Pragma("unroll") for (int m = 0; m < 4; ++m) _Pragma("unroll") for (int n = 0; n < 2; ++n) _Pragma("unroll") for (int k = 0; k < 2; ++k) \
        acc[ai][bj][m][n] = __builtin_amdgcn_mfma_f32_16x16x32_bf16(Bt[n][k], At[m][k], acc[ai][bj][m][n], 0, 0, 0); __builtin_amdgcn_s_setprio(0); } while (0)
#define PG8_WAIT_V(n) asm volatile("s_waitcnt vmcnt(" #n ")" ::: "memory")
#define PG8_WAIT_L(n) asm volatile("s_waitcnt lgkmcnt(" #n ")" ::: "memory")
#define PG8_BAR __builtin_amdgcn_s_barrier()
#define PG8_SCHED __builtin_amdgcn_sched_barrier(0)
    Unit cur, nxt; int ui = 0;
    if (!S.next(0, cur)) return;
    f32x4 acc[2][2][4][2];
#pragma unroll
    for (int a = 0; a < 2; ++a)
#pragma unroll
        for (int b = 0; b < 2; ++b)
#pragma unroll
            for (int m = 0; m < 4; ++m)
#pragma unroll
                for (int n = 0; n < 2; ++n) acc[a][b][m][n] = (f32x4){0.f, 0.f, 0.f, 0.f};
    bf16x8 At[4][2], B0[2][2], B1[2][2];
    const char* cA = (const char*)g.A + (size_t)cur.pm * tstep; const char* cB = (const char*)g.Bt + (size_t)cur.pn * tstep;
    S.a_ready(cur);
    if constexpr (SP2) {
        PG8_STAGE(PG8_SB(0, 0), cB, voffB); PG8_STAGE(PG8_SB(0, 1), cB + hstep, voffB); PG8_STAGE(PG8_SA(0, 0), cA, voffA); PG8_STAGE(PG8_SA(0, 1), cA + hstep, voffA);
        if (wr == 1) PG8_BAR;
        PG8_WAIT_V(2); PG8_BAR;
        PG8_STAGE(PG8_SB(1, 0), cB + kstep, voffB); PG8_STAGE(PG8_SA(1, 0), cA + kstep, voffA); PG8_STAGE(PG8_SB(1, 1), cB + hstep + kstep, voffB);
        PG8_WAIT_V(6); PG8_BAR;
    } else {
        PG8_STAGE(PG8_SB(0, 0), cB, voffB); PG8_STAGE(PG8_SA(0, 0), cA, voffA); PG8_STAGE(PG8_SB(0, 1), cB + hstep, voffB); PG8_STAGE(PG8_SA(0, 1), cA + hstep, voffA);
        if (wr == 1) PG8_BAR;
        PG8_WAIT_V(4); PG8_BAR;
        PG8_STAGE(PG8_SB(1, 0), cB + kstep, voffB); PG8_STAGE(PG8_SA(1, 0), cA + kstep, voffA); PG8_STAGE(PG8_SB(1, 1), cB + hstep + kstep, voffB);
        PG8_WAIT_V(6); PG8_BAR;
    }
    for (;;) {
        const bool has_next = S.next(ui + 1, nxt);
        const char* nA = has_next ? (const char*)g.A + (size_t)nxt.pm * tstep : cA; const char* nB = has_next ? (const char*)g.Bt + (size_t)nxt.pn * tstep : cB;
        for (int t = 0; t < nt; t += 2) {
            const bool last = (t == nt - 2);
            const char* a1 = cA + (size_t)(t + 1) * kstep;
            const char* a2 = last ? nA : cA + (size_t)(t + 2) * kstep; const char* b2 = last ? nB : cB + (size_t)(t + 2) * kstep;
            const char* a3 = a2 + kstep; const char* b3 = b2 + kstep;
            if (last && has_next) S.a_ready(nxt);
            if constexpr (SP2) {
            PG8_LDB(B0, 0, 0); PG8_LDB(B1, 0, 1); PG8_SCHED; PG8_LDA(At, 0, 0); PG8_STAGE(PG8_SA(1, 1), a1 + hstep, voffA);
            PG8_WAIT_V(8); PG8_WAIT_L(0); PG8_BAR; PG8_MMA(0, 0, At, B0); PG8_MMA(0, 1, At, B1); PG8_BAR; PG8_SCHED;
            PG8_LDA(At, 0, 1); PG8_STAGE(PG8_SB(0, 0), b2, voffB); PG8_STAGE(PG8_SB(0, 1), b2 + hstep, voffB); PG8_STAGE(PG8_SA(0, 0), a2, voffA);
            PG8_WAIT_V(8); PG8_WAIT_L(0); PG8_BAR; PG8_MMA(1, 0, At, B0); PG8_MMA(1, 1, At, B1); PG8_BAR; PG8_SCHED;
            PG8_LDB(B0, 1, 0); PG8_LDB(B1, 1, 1); PG8_SCHED; PG8_LDA(At, 1, 0); PG8_STAGE(PG8_SA(0, 1), a2 + hstep, voffA);
            PG8_WAIT_V(8); PG8_WAIT_L(0); PG8_BAR; PG8_MMA(0, 0, At, B0); PG8_MMA(0, 1, At, B1); PG8_BAR; PG8_SCHED;
            PG8_LDA(At, 1, 1); PG8_STAGE(PG8_SB(1, 0), b3, voffB); PG8_STAGE(PG8_SB(1, 1), b3 + hstep, voffB); PG8_STAGE(PG8_SA(1, 0), a3, voffA);
            PG8_WAIT_V(8); PG8_WAIT_L(0); PG8_BAR; PG8_MMA(1, 0, At, B0); PG8_MMA(1, 1, At, B1); PG8_BAR; PG8_SCHED;
            } else {
            PG8_LDB(B0, 0, 0); PG8_SCHED; PG8_LDA(At, 0, 0); PG8_STAGE(PG8_SA(1, 1), a1 + hstep, voffA);
            PG8_WAIT_L(8); PG8_BAR; PG8_WAIT_L(0); PG8_MMA(0, 0, At, B0); PG8_BAR; PG8_SCHED;
            PG8_LDB(B1, 0, 1); PG8_STAGE(PG8_SB(0, 0), b2, voffB);
            PG8_BAR; PG8_WAIT_L(0); PG8_MMA(0, 1, At, B1); PG8_BAR;
            PG8_LDA(At, 0, 1); PG8_STAGE(PG8_SA(0, 0), a2, voffA);
            PG8_BAR; PG8_WAIT_L(0); PG8_MMA(1, 0, At, B0); PG8_BAR; PG8_SCHED;
            PG8_STAGE(PG8_SB(0, 1), b2 + hstep, voffB);
            PG8_WAIT_V(6); PG8_BAR; PG8_MMA(1, 1, At, B1); PG8_BAR;
            PG8_LDB(B0, 1, 0); PG8_SCHED; PG8_LDA(At, 1, 0); PG8_STAGE(PG8_SA(0, 1), a2 + hstep, voffA);
            PG8_WAIT_L(8); PG8_BAR; PG8_WAIT_L(0); PG8_MMA(0, 0, At, B0); PG8_BAR; PG8_SCHED;
            PG8_LDB(B1, 1, 1); PG8_STAGE(PG8_SB(1, 0), b3, voffB);
            PG8_BAR; PG8_WAIT_L(0); PG8_MMA(0, 1, At, B1); PG8_BAR;
            PG8_LDA(At, 1, 1); PG8_STAGE(PG8_SA(1, 0), a3, voffA);
            PG8_BAR; PG8_WAIT_L(0); PG8_MMA(1, 0, At, B0); PG8_BAR; PG8_SCHED;
            PG8_STAGE(PG8_SB(1, 1), b3 + hstep, voffB);
            PG8_WAIT_V(6); PG8_BAR; PG8_MMA(1, 1, At, B1); PG8_BAR;
            }
        }
        if constexpr (ALIGN_EPI) { if (wr == 0) PG8_BAR; }
        if constexpr (!Epi::AFTER_DRAIN) { E(acc, cur, wr, wc, fr, fq); S.done(cur); }
        if (!has_next) break;
#pragma unroll
        for (int a = 0; a < 2; ++a)
#pragma unroll
            for (int b = 0; b < 2; ++b)
#pragma unroll
                for (int m = 0; m < 4; ++m)
#pragma unroll
                    for (int n = 0; n < 2; ++n) acc[a][b][m][n] = (f32x4){0.f, 0.f, 0.f, 0.f};
        cur = nxt; cA = nA; cB = nB; ++ui;
        if constexpr (ALIGN_EPI) { if (wr == 1) PG8_BAR; }
    }
    PG8_WAIT_V(0);
    if constexpr (!ALIGN_EPI) { if (wr == 0) PG8_BAR; }
    PG8_BAR;
    if constexpr (Epi::AFTER_DRAIN) { E.fused(acc, cur, wr, wc, fr, fq, lds, wid, lane); S.done(cur); }
#undef PG8_SA
#undef PG8_SB
#undef PG8_STAGE
#undef PG8_LDA
#undef PG8_LDB
#undef PG8_MMA
#undef PG8_WAIT_V
#undef PG8_WAIT_L
#undef PG8_BAR
#undef PG8_SCHED
}

__device__ __forceinline__ float row_rstd(const float* ssq, int row) {
    const f32x4 a = *(const f32x4*)(ssq + (size_t)row * 8), b = *(const f32x4*)(ssq + (size_t)row * 8 + 4);
    return __builtin_amdgcn_rsqf(((a[0] + a[1]) + (a[2] + a[3]) + (b[0] + b[1]) + (b[2] + b[3])) * (1.0f / 2048.0f) + 1e-6f);
}
struct EpiBf16S {
    static constexpr bool PERM = true, AFTER_DRAIN = false;
    bf16_t* O; int ldc; const float* ssq;
    __device__ __forceinline__ void operator()(f32x4 (&acc)[2][2][4][2], const Unit& u, int wr, int wc, int fr, int fq) const {
        { int l_ = threadIdx.x & 63; asm volatile("" : "+v"(l_)); fr = l_ & 15; fq = l_ >> 4; }
        const int row0 = u.pm * BM + wr * 64 + fr; const int col0 = u.pn * BM + wc * 32 + 8 * fq;
#pragma unroll
        for (int ai = 0; ai < 2; ++ai)
#pragma unroll
            for (int m = 0; m < 4; ++m) { const int row = row0 + ai * HALF + m * 16; bf16_t* rowp = O + (size_t)row * ldc + col0;
                const float rs = ssq ? row_rstd(ssq, row) : 1.0f;
#pragma unroll
                for (int bj = 0; bj < 2; ++bj) { const f32x4 v0 = acc[ai][bj][m][0] * rs, v1 = acc[ai][bj][m][1] * rs;
                    u32x4 w; w.x = cvt_pk_bf16(v0[0], v0[1]); w.y = cvt_pk_bf16(v0[2], v0[3]); w.z = cvt_pk_bf16(v1[0], v1[1]); w.w = cvt_pk_bf16(v1[2], v1[3]);
                    *(u32x4*)(rowp + bj * HALF) = w; } }
    }
};
struct EpiResNorm {
    static constexpr bool PERM = true, AFTER_DRAIN = false;
    bf16_t* hb; float* ssq; bf16_t* xh; PG8_LAS unsigned char* xch; int ldc;
    __device__ __forceinline__ void operator()(f32x4 (&acc)[2][2][4][2], const Unit& u, int wr, int wc, int fr, int fq) const {
        { int l_ = threadIdx.x & 63; asm volatile("" : "+v"(l_)); fr = l_ & 15; fq = l_ >> 4; }
        const int col0 = u.pn * BM + wc * 32 + 8 * fq;
        PG8_LAS float* P = (PG8_LAS float*)xch;
        const unsigned off0 = (unsigned)((u.pm * BM + wr * 64 + fr) * ldc + col0);
        u32x4 nb[2];
#pragma unroll
        for (int bj = 0; bj < 2; ++bj) nb[bj] = *(const u32x4*)(hb + off0 + bj * HALF);
#pragma unroll
        for (int ai = 0; ai < 2; ++ai)
#pragma unroll
            for (int m = 0; m < 4; ++m) { const int rl = ai * HALF + wr * 64 + m * 16 + fr; const unsigned off = off0 + (unsigned)((ai * HALF + m * 16) * ldc);
                const u32x4 c0 = nb[0], c1 = nb[1];
                if (ai * 4 + m < 7) { const unsigned offn = off0 + (unsigned)((((ai * 4 + m + 1) >> 2) * HALF + ((ai * 4 + m + 1) & 3) * 16) * ldc);
#pragma unroll
                    for (int bj = 0; bj < 2; ++bj) nb[bj] = *(const u32x4*)(hb + offn + bj * HALF); }
                asm volatile("" ::: "memory");
                float ss = 0.f;
#pragma unroll
                for (int bj = 0; bj < 2; ++bj) { const u32x4 cw = bj == 0 ? c0 : c1;
                    f32x4 b0, b1;
                    b0[0] = __uint_as_float(cw[0] << 16); b0[1] = __uint_as_float(cw[0] & 0xffff0000u); b0[2] = __uint_as_float(cw[1] << 16); b0[3] = __uint_as_float(cw[1] & 0xffff0000u);
                    b1[0] = __uint_as_float(cw[2] << 16); b1[1] = __uint_as_float(cw[2] & 0xffff0000u); b1[2] = __uint_as_float(cw[3] << 16); b1[3] = __uint_as_float(cw[3] & 0xffff0000u);
                    const f32x4 v0 = b0 + acc[ai][bj][m][0], v1 = b1 + acc[ai][bj][m][1];
                    ss += (v0[0] * v0[0] + v0[1] * v0[1]) + (v0[2] * v0[2] + v0[3] * v0[3]) + (v1[0] * v1[0] + v1[1] * v1[1]) + (v1[2] * v1[2] + v1[3] * v1[3]);
                    u32x4 w; w.x = cvt_pk_bf16(v0[0], v0[1]); w.y = cvt_pk_bf16(v0[2], v0[3]); w.z = cvt_pk_bf16(v1[0], v1[1]); w.w = cvt_pk_bf16(v1[2], v1[3]);
                    *(u32x4*)(hb + off + bj * HALF) = w;
                    if (xh != nullptr && ai == 1 && m == 3 && wr == 1 && fr >= 14) { const int p = u.pm + 1;
                        if (p < 128 && (p & 7) != 0) *(u32x4*)(xh + (unsigned)((2 * p + fr - 14) * ldc + col0 + bj * HALF)) = w; }
                }
                ss += __shfl_xor(ss, 16); ss += __shfl_xor(ss, 32);
                if (fq == 0) P[rl * 4 + wc] = ss;
            }
        asm volatile("s_waitcnt lgkmcnt(0)" ::: "memory"); __builtin_amdgcn_s_barrier(); asm volatile("" ::: "memory");
        const int t = (wr * 4 + wc) * 64 + fq * 16 + fr;
        if (t < BM) { const f32x4 q = *(const PG8_LAS f32x4*)(P + t * 4); ssq[(size_t)(u.pm * BM + t) * 8 + u.pn] = (q[0] + q[1]) + (q[2] + q[3]); }
    }
};
struct EpiF32 {
    static constexpr bool PERM = false, AFTER_DRAIN = false;
    float* out; int ldc; const float* ssq;
    __device__ __forceinline__ void operator()(f32x4 (&acc)[2][2][4][2], const Unit& u, int wr, int wc, int fr, int fq) const {
        { int l_ = threadIdx.x & 63; asm volatile("" : "+v"(l_)); fr = l_ & 15; fq = l_ >> 4; }
        const int col0 = u.pn * BM + wc * 32 + 4 * fq;
#pragma unroll
        for (int ai = 0; ai < 2; ++ai)
#pragma unroll
            for (int m = 0; m < 4; ++m) { const int r = u.pm * BM + ai * HALF + wr * 64 + m * 16 + fr; const size_t off = (size_t)r * ldc + col0;
                int src = 256 * (r >> 1) - 2 + (r & 1); src = src < 0 ? 0 : src;
                const float rs = row_rstd(ssq, src);
#pragma unroll
                for (int bj = 0; bj < 2; ++bj)
#pragma unroll
                    for (int n = 0; n < 2; ++n) *(f32x4*)(out + off + bj * HALF + n * 16) = acc[ai][bj][m][n] * rs; }
    }
};
typedef unsigned u32x2 __attribute__((ext_vector_type(2)));
struct EpiConvGlu {
    static constexpr bool PERM = true, AFTER_DRAIN = false;
    bf16_t* act; const float* cw; const float* cb; const float* halo; const float* rstd; PG8_LAS unsigned char* xch; int dff; int nup;
    __device__ __forceinline__ void operator()(f32x4 (&acc)[2][2][4][2], const Unit& u, int wr, int wc, int fr, int fq) const {
        { int l_ = threadIdx.x & 63; asm volatile("" : "+v"(l_), "+s"(wr), "+s"(wc)); fr = l_ & 15; fq = l_ >> 4; }
        const int lane = fq * 16 + fr;
        PG8_LAS f32x4* X = (PG8_LAS f32x4*)xch;
#pragma unroll
        for (int ai = 0; ai < 2; ++ai) {
            float rs[4];
#pragma unroll
            for (int m = 0; m < 4; ++m) rs[m] = rstd[u.pm * BM + ai * HALF + wr * 64 + m * 16 + fr];
#pragma unroll
            for (int m = 0; m < 4; ++m)
#pragma unroll
                for (int bj = 0; bj < 2; ++bj)
#pragma unroll
                    for (int n = 0; n < 2; ++n) acc[ai][bj][m][n] = acc[ai][bj][m][n] * rs[m];
            asm volatile("" ::: "memory"); }
        if (fr >= 14) {
#pragma unroll
            for (int ai = 0; ai < 2; ++ai)
#pragma unroll
                for (int bj = 0; bj < 2; ++bj)
#pragma unroll
                    for (int n = 0; n < 2; ++n) X[((((ai * 2 + wr) * 4 + wc) * 2 + bj) * 2 + n) * 8 + fq * 2 + (fr - 14)] = acc[ai][bj][3][n];
        }
        asm volatile("s_waitcnt lgkmcnt(0)" ::: "memory"); __builtin_amdgcn_s_barrier(); asm volatile("" ::: "memory");
        const int chb = u.pn * HALF + wc * 32 + 8 * fq;
        const int src1 = ((lane & 48) | ((fr + 15) & 15)) << 2, src2 = ((lane & 48) | ((fr + 14) & 15)) << 2;
        f32x4 hal[2][2];
#pragma unroll
        for (int n = 0; n < 2; ++n)
#pragma unroll
            for (int bj = 0; bj < 2; ++bj) { f32x4 v = (f32x4){0.f, 0.f, 0.f, 0.f};
                if (fr >= 14 && wr == 0 && (u.pm & 7) != 0) v = *(const f32x4*)(halo + (unsigned)((2 * u.pm + fr - 14) * nup + u.pn * BM + bj * HALF + wc * 32 + 8 * fq + 4 * n));
                hal[n][bj] = v; }
        u32x2 keep[2][4];
#pragma unroll
        for (int n = 0; n < 2; ++n) {
            f32x4 cwv[2][3], cbv[2];
#pragma unroll
            for (int bj = 0; bj < 2; ++bj) { const int ch = bj * dff + chb + 4 * n;
                cwv[bj][0] = *(const f32x4*)(cw + ch); cwv[bj][1] = *(const f32x4*)(cw + nup + ch); cwv[bj][2] = *(const f32x4*)(cw + 2 * nup + ch); cbv[bj] = *(const f32x4*)(cb + ch); }
#pragma unroll
            for (int ai = 0; ai < 2; ++ai) {
                f32x4 bnd[2];
#pragma unroll
                for (int bj = 0; bj < 2; ++bj) {
                    f32x4 v = (f32x4){0.f, 0.f, 0.f, 0.f};
                    if (fr >= 14) {
                        if (ai == 0 && wr == 0) v = hal[n][bj];
                        else { const int pai = (wr == 1) ? ai : 0, pwr = (wr == 1) ? 0 : 1;
                               v = X[((((pai * 2 + pwr) * 4 + wc) * 2 + bj) * 2 + n) * 8 + fq * 2 + (fr - 14)]; }
                    }
                    bnd[bj] = v;
                }
#pragma unroll
                for (int m = 0; m < 4; ++m) {
                    float a[4];
#pragma unroll
                    for (int j = 0; j < 4; ++j) {
                        float hc[2];
#pragma unroll
                        for (int bj = 0; bj < 2; ++bj) {
                            const float cur = acc[ai][bj][m][n][j];
                            const float prv = (m == 0) ? bnd[bj][j] : acc[ai][bj][m == 0 ? 0 : m - 1][n][j];
                            const float p1 = __int_as_float(__builtin_amdgcn_update_dpp(__builtin_amdgcn_mov_dpp(__float_as_int(prv), 0x121, 0xf, 0xf, false), __float_as_int(cur), 0x111, 0xf, 0xf, false));
                            const float p2 = __int_as_float(__builtin_amdgcn_update_dpp(__builtin_amdgcn_mov_dpp(__float_as_int(prv), 0x122, 0xf, 0xf, false), __float_as_int(cur), 0x112, 0xf, 0xf, false));
                            hc[bj] = cwv[bj][0][j] * p2 + cwv[bj][1][j] * p1 + cwv[bj][2][j] * cur + cbv[bj][j];
                        }
                        a[j] = hc[0] * hc[1] * __builtin_amdgcn_rcpf(1.0f + __builtin_amdgcn_exp2f(hc[0] * -1.4426950408889634f));
                    }
                    u32x2 w; w.x = cvt_pk_bf16(a[0], a[1]); w.y = cvt_pk_bf16(a[2], a[3]);
                    if (n == 0) { keep[ai][m] = w; asm volatile("" : "+v"(keep[ai][m].x), "+v"(keep[ai][m].y) :: "memory"); }
                    else { u32x4 w4; w4.x = keep[ai][m].x; w4.y = keep[ai][m].y; w4.z = w.x; w4.w = w.y;
                        *(u32x4*)(act + (unsigned)((u.pm * BM + ai * HALF + wr * 64 + m * 16 + fr) * dff + chb)) = w4; }
                }
            }
        }
    }
};
}

#ifndef PG8_SP2
#define PG8_SP2 true
#endif
#ifndef PG8_ALIGN
#define PG8_ALIGN true
#endif
#ifndef MK_ONE_LAUNCH
#define MK_ONE_LAUNCH 1
#endif

constexpr int NWAVES = 8;
constexpr int NB = 16, SEQ = 2048, D = 2048, T = NB * SEQ, NLAYER = 4;
constexpr int NMEM = 256, MROWS = NB * NMEM;
constexpr int NPROJ = 4608;
constexpr int DFF = 5632, NUP = 2 * DFF;
constexpr int DXA = 512;
constexpr float EPS = 1e-6f;
constexpr int C_DQ = 0, C_DK = 512, C_DV = 1024, C_SQ = 1536, C_SK = 2560, C_SV = 2688, C_GQ = 2816, C_GK = 3072, C_GV = 3328, C_OG = 3840, C_Z = 4352;
constexpr int WIN_LD = 4368;
constexpr int M_DIFF = 0, M_SWA = 512, M_GLA = 1536;

constexpr size_t MiB = 1u << 20;
constexpr size_t WS_CTL = 0, CTL_ZERO_BYTES = 192 * 1024;
constexpr size_t WS_PAR = 1 * MiB;
constexpr size_t WS_W = 2 * MiB, WL_STRIDE = 96 * MiB;
constexpr size_t WO_IN = 0, WO_OUT = 18 * MiB, WO_XQ = 26 * MiB, WO_XO = 28 * MiB, WO_UP = 30 * MiB, WO_DN = 74 * MiB;
constexpr size_t WS_WKV = WS_W + NLAYER * WL_STRIDE;
constexpr size_t WS_MEMN = WS_WKV + 16 * MiB;
constexpr size_t WS_KVMEM = WS_MEMN + 16 * MiB;
constexpr size_t WS_XN = WS_KVMEM + 32 * MiB;
constexpr size_t WS_QXA = WS_XN + 128 * MiB;
constexpr size_t WS_OXA = WS_QXA + 32 * MiB;
constexpr size_t WS_XH = WS_OXA + 32 * MiB;
constexpr size_t WS_HALO = WS_XH + 1 * MiB;
constexpr size_t WS_OGLA = WS_HALO + 11 * MiB;
constexpr size_t WS_PROJ = WS_OGLA + 64 * MiB;
constexpr size_t WS_GQD = WS_PROJ + 352 * MiB;
constexpr size_t WS_GKI = WS_GQD + 16 * MiB;
constexpr size_t WS_GEB = WS_GKI + 16 * MiB;
constexpr size_t WS_HB = WS_GEB + 1 * MiB;
constexpr size_t WS_SSQ = WS_HB + 128 * MiB;
constexpr size_t WS_RSTD = WS_SSQ + 1 * MiB;
constexpr size_t WS_DKV = WS_RSTD + 1 * MiB;
constexpr size_t WS_SKV = WS_DKV + 64 * MiB;
constexpr size_t WS_GVF = WS_SKV + 16 * MiB;
constexpr size_t WS_END = WS_GVF + 32 * MiB;
static_assert((size_t)NPROJ * D * 2 == 18 * MiB && (size_t)NUP * D * 2 == 44 * MiB && (size_t)D * DFF * 2 == 22 * MiB && (size_t)256 * NUP * 4 == 11 * MiB, "weight map");
static_assert(WS_END <= (size_t)1408 * MiB, "d_ws is at least 4 x ffn_w_up = 1408 MiB");
constexpr int PA_NMIX = 0, PA_NXA = 8192, PA_NFFN = 16384, PA_FIN = 24576, PA_LAM = 26624, PA_SUB = 27136, PA_SINK = 27392, PA_GB = 27456, PA_GNG = 28480, PA_CW = 28992, PA_CB = 164160, PA_PTRS = 209216  , PA_END = 209232;
static_assert((size_t)PA_END * 4 <= MiB, "parameter block");
constexpr int CW_BAR = 4096;

constexpr int RING_OFF = 0, RING_BYTES = 131072;
constexpr int XCH_OFF = RING_BYTES, XCH_BYTES = 8192;
constexpr int MISC_OFF = XCH_OFF + XCH_BYTES;
constexpr int LDS_BYTES = 147456;
static_assert(MISC_OFF + 128 <= LDS_BYTES, "LDS map");

#define GAS __attribute__((address_space(1)))
#define LAS __attribute__((address_space(3)))
typedef unsigned short bf16;
typedef unsigned v4u __attribute__((ext_vector_type(4)));
typedef unsigned v2u __attribute__((ext_vector_type(2)));
typedef float f32x4 __attribute__((ext_vector_type(4)));
typedef GAS unsigned gu32;
#define RLX_AGENT __ATOMIC_RELAXED, __HIP_MEMORY_SCOPE_AGENT
#define LDS_WAIT() asm volatile("s_waitcnt lgkmcnt(0)" ::: "memory")
__device__ __forceinline__ unsigned f2bf(float f) { unsigned u = __builtin_bit_cast(unsigned, f); return (u + 0x7fffu + ((u >> 16) & 1u)) >> 16; }
__device__ __forceinline__ unsigned pk2(float lo, float hi) { return f2bf(lo) | (f2bf(hi) << 16); }
__device__ __forceinline__ float bflo(unsigned w) { return __uint_as_float(w << 16); }
__device__ __forceinline__ float bfhi(unsigned w) { return __uint_as_float(w & 0xffff0000u); }
__device__ __forceinline__ float bf1(const bf16* p) { return __uint_as_float((unsigned)(*p) << 16); }
__device__ __forceinline__ float wave_sum(float v) {
#pragma unroll
    for (int o = 1; o < 64; o <<= 1) v += __shfl_xor(v, o);
    return v;
}

__host__ __device__ __forceinline__ size_t dkv_off(int b, int head, int kt, int f) { return ((((size_t)(b * 8 + head) * 64 + kt) * 8 + f) * 64) * 8; }
__host__ __device__ __forceinline__ size_t skv_off(int b, int g, int kt, int f) { return ((((size_t)(b * 2 + g) * 64 + kt) * 8 + f) * 64) * 8; }
__host__ __device__ __forceinline__ size_t gvf_off(int b, int head, int kt, int vq, int f) { return ((((((size_t)(b * 4 + head) * 64 + kt) * 4 + vq) * 2 + f) * 64)) * 8; }
__host__ __device__ __forceinline__ size_t xkv_off(int layer, int b, int head, int kt, int f) { return ((((((size_t)(layer * 16 + b) * 4 + head) * 8 + kt) * 16 + f) * 64)) * 8; }
namespace pg8 {
struct EpiProj {
    static constexpr bool PERM = true, AFTER_DRAIN = false;
    bf16_t* O; int ldc; const float* ssq; bf16_t* dkv; bf16_t* skv; bf16_t* gvf;
    __device__ __forceinline__ void operator()(f32x4 (&acc)[2][2][4][2], const Unit& u, int wr, int wc, int fr, int fq) const {
        { int l_ = threadIdx.x & 63; asm volatile("" : "+v"(l_)); fr = l_ & 15; fq = l_ >> 4; }
        const int row0 = u.pm * BM + wr * 64 + fr; const int col0 = u.pn * BM + wc * 32 + 8 * fq;
        const int pn = u.pn; const int kind = (pn >= 2 && pn <= 5) ? 1 : (pn == 10 ? 2 : ((pn == 13 || pn == 14) ? 3 : 0));
        const int hh = fq & 1, b = u.pm >> 3;
#pragma unroll
        for (int ai = 0; ai < 2; ++ai)
#pragma unroll
            for (int m = 0; m < 4; ++m) { const int row = row0 + ai * HALF + m * 16;
                const float rs = row_rstd(ssq, row);
                const int s = row & 2047, kt = s >> 5, ln = (s & 31) + 32 * hh;
#pragma unroll
                for (int bj = 0; bj < 2; ++bj) { const f32x4 v0 = acc[ai][bj][m][0] * rs, v1 = acc[ai][bj][m][1] * rs;
                    u32x4 w; w.x = cvt_pk_bf16(v0[0], v0[1]); w.y = cvt_pk_bf16(v0[2], v0[3]); w.z = cvt_pk_bf16(v1[0], v1[1]); w.w = cvt_pk_bf16(v1[2], v1[3]);
                    const int c = col0 + bj * HALF;
                    bf16_t* dst;
                    if (kind == 0) dst = O + (size_t)row * ldc + c;
                    else if (kind == 1) { const int isv = c >= 1024, cc = c - (isv ? 1024 : 512); dst = dkv + dkv_off(b, cc >> 6, kt, isv * 4 + ((cc & 63) >> 4)) + ln * 8; }
                    else if (kind == 2) { const int cc = c - 2560, isv = cc >> 7; dst = skv + skv_off(b, (cc & 127) >> 6, kt, isv * 4 + ((cc & 63) >> 4)) + ln * 8; }
                    else { const int cc = c - 3328; dst = gvf + gvf_off(b, cc >> 7, kt, (cc & 127) >> 5, (cc & 31) >> 4) + ln * 8; }
                    *(u32x4*)dst = w; } }
    }
};
struct EpiKvFrag {
    static constexpr bool PERM = true, AFTER_DRAIN = false;
    bf16_t* xkv;
    __device__ __forceinline__ void operator()(f32x4 (&acc)[2][2][4][2], const Unit& u, int wr, int wc, int fr, int fq) const {
        { int l_ = threadIdx.x & 63; asm volatile("" : "+v"(l_)); fr = l_ & 15; fq = l_ >> 4; }
        const int col0 = u.pn * BM + wc * 32 + 8 * fq; const int hh = fq & 1, b = u.pm;
#pragma unroll
        for (int ai = 0; ai < 2; ++ai)
#pragma unroll
            for (int m = 0; m < 4; ++m) { const int mrow = ai * HALF + wr * 64 + m * 16 + fr; const int kt = mrow >> 5, ln = (mrow & 31) + 32 * hh;
#pragma unroll
                for (int bj = 0; bj < 2; ++bj) { const f32x4 v0 = acc[ai][bj][m][0], v1 = acc[ai][bj][m][1];
                    u32x4 w; w.x = cvt_pk_bf16(v0[0], v0[1]); w.y = cvt_pk_bf16(v0[2], v0[3]); w.z = cvt_pk_bf16(v1[0], v1[1]); w.w = cvt_pk_bf16(v1[2], v1[3]);
                    const int c = col0 + bj * HALF; const int layer = c >> 10, within = c & 1023, isv = within >> 9, head = (within & 511) >> 7, d = within & 127;
                    *(u32x4*)(xkv + xkv_off(layer, b, head, kt, isv * 8 + (d >> 4)) + ln * 8) = w; } }
    }
};
}
#define XB_TMO      128
#define XB_XCNT(j)  (256  + 64 * (j))
#define XB_XSUB(j)  (1280 + 64 * (j))
#define XB_XGEN(j)  (2304 + 64 * (j))
#define XB_TOP      3328
#define XB_TOPGEN   3392
#define XCD_BAR_WORDS 3456
#define XB_SPIN_CAP (1u << 22)

__device__ __forceinline__ unsigned xb_ld(unsigned* p)              { return __hip_atomic_load(p, __ATOMIC_RELAXED, __HIP_MEMORY_SCOPE_AGENT); }
__device__ __forceinline__ unsigned xb_add(unsigned* p, unsigned v) { return __hip_atomic_fetch_add(p, v, __ATOMIC_RELAXED, __HIP_MEMORY_SCOPE_AGENT); }
__device__ __forceinline__ unsigned xb_xcc_id() { return (unsigned)__builtin_amdgcn_s_getreg((3 << 11) | 20) & 0xFu; }
#define XB_SPIN(cond, bar) do { unsigned _sp = 0; while (cond) { __builtin_amdgcn_s_sleep(1); \
    if ((++_sp & 255u) == 0u) { if (xb_ld(&(bar)[XB_TMO])) break; if (_sp > XB_SPIN_CAP) { atomicAdd(&(bar)[XB_TMO], 1u); break; } } } } while (0)

struct XcdBarrier {
    unsigned* bar; unsigned x;
    volatile LAS unsigned* st;
};

__device__ __forceinline__ XcdBarrier xcd_barrier_post(unsigned* bar, volatile LAS unsigned* st) {
    XcdBarrier b; b.bar = bar; b.x = xb_xcc_id(); b.st = st;
    if (threadIdx.x == 0) (void)xb_add(&bar[XB_XCNT(b.x)], 1u);
    return b;
}
__device__ __forceinline__ void xcd_barrier_complete(unsigned* bar, unsigned x, unsigned& nloc, unsigned& nx) {
    const unsigned G = gridDim.x * gridDim.y * gridDim.z;
    unsigned sum, cnt, mine, sp = 0u;
    for (;;) {
        sum = 0u; cnt = 0u; mine = 0u;
#pragma unroll
        for (unsigned j = 0; j < 16; ++j) { const unsigned c = xb_ld(&bar[XB_XCNT(j)]); sum += c; cnt += (c > 0u) ? 1u : 0u; mine = (j == x) ? c : mine; }
        if (sum == G) break;
        __builtin_amdgcn_s_sleep(1);
        if ((++sp & 255u) == 0u) { if (xb_ld(&bar[XB_TMO])) break; if (sp > XB_SPIN_CAP) { atomicAdd(&bar[XB_TMO], 1u); break; } }
    }
    nloc = mine > 0u ? mine : 1u; nx = cnt > 0u ? cnt : 1u;
}

__device__ __forceinline__ void xcd_barrier(const XcdBarrier& b) {
    asm volatile("s_waitcnt vmcnt(0)" ::: "memory");
    __syncthreads();
    if (threadIdx.x == 0) {
        __attribute__((address_space(1))) unsigned* barg_ = (__attribute__((address_space(1))) unsigned*)b.bar; unsigned bx_ = b.x;
        asm volatile("" : "+s"(barg_), "+s"(bx_));
        unsigned* bar = (unsigned*)barg_;
        __builtin_amdgcn_s_waitcnt(0);
        unsigned nloc = b.st[0], nx = b.st[1];
        if (nloc == 0u) { xcd_barrier_complete(bar, bx_, nloc, nx); b.st[0] = nloc; b.st[1] = nx; }
        const unsigned old = xb_add(&bar[XB_XSUB(bx_)], 1u);
        const unsigned gen = old / nloc;
        if (old + 1u == (gen + 1u) * nloc) {
            __builtin_amdgcn_fence(__ATOMIC_RELEASE, "agent");
            asm volatile("s_waitcnt vmcnt(0)" ::: "memory");
            const unsigned og = xb_add(&bar[XB_TOP], 1u);
            const unsigned tg = og / nx;
            if (og + 1u == (tg + 1u) * nx) xb_add(&bar[XB_TOPGEN], 1u);
            else XB_SPIN(xb_ld(&bar[XB_TOPGEN]) == tg, bar);
            __builtin_amdgcn_fence(__ATOMIC_ACQUIRE, "agent");
            xb_add(&bar[XB_XGEN(bx_)], 1u);
            asm volatile("s_waitcnt vmcnt(0)" ::: "memory");
        } else {
            XB_SPIN(xb_ld(&bar[XB_XGEN(bx_)]) == gen, bar);
            __builtin_amdgcn_fence(__ATOMIC_ACQUIRE, "agent");
            asm volatile("s_waitcnt vmcnt(0)" ::: "memory");
        }
    }
    __syncthreads();
}


__device__ __forceinline__ void transpose_item(const float* W, int ldn, int k0, int n0s, bf16* WT, int K, int n0d, LAS float* scr, int lane, const float* gk) {
    float wv[32], gv[32];
    { const float* wp = W + (size_t)(k0 + (lane >> 5)) * ldn + n0s + (lane & 31);
#pragma unroll
      for (int i = 0; i < 32; ++i) wv[i] = wp[(size_t)(2 * i) * ldn];
      if (gk) {
#pragma unroll
          for (int i = 0; i < 32; ++i) gv[i] = gk[k0 + 2 * i + (lane >> 5)]; }
    }
#pragma unroll
    for (int i = 0; i < 32; ++i) { const int kk = 2 * i + (lane >> 5); scr[kk * 33 + (lane & 31)] = gk ? wv[i] * gv[i] : wv[i]; }
    LDS_WAIT(); asm volatile("" ::: "memory");
    const int c = lane & 7;
#pragma unroll
    for (int j = 0; j < 4; ++j) { const int n = (lane >> 3) + 8 * j; const LAS float* s = scr + (8 * c) * 33 + n;
        v4u o; o.x = pk2(s[0 * 33], s[1 * 33]); o.y = pk2(s[2 * 33], s[3 * 33]); o.z = pk2(s[4 * 33], s[5 * 33]); o.w = pk2(s[6 * 33], s[7 * 33]);
        *(GAS v4u*)(WT + (size_t)(n0d + n) * K + k0 + 8 * c) = o; }
    LDS_WAIT(); asm volatile("" ::: "memory");
}

struct Ptrs {
    const float* in[22]; float* out; unsigned char* ws;
};
__device__ __forceinline__ bf16* wlp(unsigned char* ws, int l, size_t off) { return (bf16*)(ws + WS_W + (size_t)l * WL_STRIDE + off); }
__device__ __forceinline__ bf16* wl(const Ptrs& P, int l, size_t off) { return wlp(P.ws, l, off); }

__device__ __forceinline__ void rms_row_to_bf16(const float* xrow, const float* g, bf16* orow, bf16* orow2, int lane) {
    const GAS f32x4* xr = (const GAS f32x4*)xrow + lane;
    f32x4 v[8]; float s = 0.f;
#pragma unroll
    for (int j = 0; j < 8; ++j) { v[j] = xr[64 * j]; s += (v[j].x * v[j].x + v[j].y * v[j].y) + (v[j].z * v[j].z + v[j].w * v[j].w); }
    const float rstd = 1.0f / sqrtf(wave_sum(s) * (1.f / D) + EPS);
    GAS v2u* o8 = (GAS v2u*)orow + lane; GAS v2u* o82 = (GAS v2u*)orow2 + lane;
#pragma unroll
    for (int j = 0; j < 8; ++j) {
        f32x4 y = v[j] * rstd;
        if (g) y = y * ((const GAS f32x4*)g)[lane + 64 * j];
        v2u w; w.x = pk2(y.x, y.y); w.y = pk2(y.z, y.w);
        o8[64 * j] = w; if (orow2) o82[64 * j] = w;
    }
}
__device__ __forceinline__ void rms_row_final(const bf16* hrow, float* orow, const float* g, const float* ssq8, int lane) {
    const f32x4 a = *(const GAS f32x4*)ssq8, b = *(const GAS f32x4*)(ssq8 + 4);
    const float rstd = 1.0f / sqrtf(((a.x + a.y) + (a.z + a.w) + (b.x + b.y) + (b.z + b.w)) * (1.f / D) + EPS);
    const GAS v2u* hr = (const GAS v2u*)hrow + lane; GAS f32x4* o = (GAS f32x4*)orow + lane;
#pragma unroll
    for (int j = 0; j < 8; ++j) { const v2u w = hr[64 * j]; const f32x4 gg = ((const GAS f32x4*)g)[lane + 64 * j];
        f32x4 y; y.x = bflo(w.x) * rstd * gg.x; y.y = bfhi(w.x) * rstd * gg.y; y.z = bflo(w.y) * rstd * gg.z; y.w = bfhi(w.y) * rstd * gg.w; o[64 * j] = y; }
}
__device__ __forceinline__ void rms_row_final2(const bf16* h0, const bf16* h1, float* o0p, float* o1p, const float* g, const float* ssqa, const float* ssqb, int lane) {
    const f32x4 a0 = *(const GAS f32x4*)ssqa, b0 = *(const GAS f32x4*)(ssqa + 4), a1 = *(const GAS f32x4*)ssqb, b1 = *(const GAS f32x4*)(ssqb + 4);
    const GAS v2u* hr0 = (const GAS v2u*)h0 + lane; const GAS v2u* hr1 = (const GAS v2u*)h1 + lane;
    v2u w0[8], w1[8];
#pragma unroll
    for (int j = 0; j < 8; ++j) { w0[j] = hr0[64 * j]; w1[j] = hr1[64 * j]; }
    const float r0 = 1.0f / sqrtf(((a0.x + a0.y) + (a0.z + a0.w) + (b0.x + b0.y) + (b0.z + b0.w)) * (1.f / D) + EPS);
    const float r1 = 1.0f / sqrtf(((a1.x + a1.y) + (a1.z + a1.w) + (b1.x + b1.y) + (b1.z + b1.w)) * (1.f / D) + EPS);
    GAS f32x4* o0 = (GAS f32x4*)o0p + lane; GAS f32x4* o1 = (GAS f32x4*)o1p + lane;
#pragma unroll
    for (int j = 0; j < 8; ++j) { const f32x4 gg = ((const GAS f32x4*)g)[lane + 64 * j];
        f32x4 y; y.x = bflo(w0[j].x) * r0 * gg.x; y.y = bfhi(w0[j].x) * r0 * gg.y; y.z = bflo(w0[j].y) * r0 * gg.z; y.w = bfhi(w0[j].y) * r0 * gg.w; o0[64 * j] = y;
        f32x4 z; z.x = bflo(w1[j].x) * r1 * gg.x; z.y = bfhi(w1[j].x) * r1 * gg.y; z.z = bflo(w1[j].y) * r1 * gg.z; z.w = bfhi(w1[j].y) * r1 * gg.w; o1[64 * j] = z; }
}

constexpr int TI_INA = 32 * 120, TI_INB = 32 * 16, TI_OUT = 32 * 64, TI_XQ = 32 * 16, TI_KV = 32 * 32, TI_XO = 8 * 64, TI_UP = 32 * 352, TI_DN = 88 * 64;
constexpr int TI_LAYER = TI_INA + TI_INB + TI_OUT + TI_XQ + TI_KV + TI_XO + TI_UP + TI_DN;
struct WSrc { const float* w_in; const float* w_out; const float* xa_wq; const float* xa_wo; const float* w_up; const float* w_dn; const float* g_mix; const float* g_xa; const float* g_ffn; };
constexpr int TI_LAYER_NOKV = TI_LAYER - TI_KV;
__device__ __forceinline__ void convert_layer_item(const WSrc& W, unsigned char* ws, int l, int r, LAS float* scr, int lane) {
    if (r < TI_INA) { const int kb = r / 120, nb = r % 120; transpose_item(W.w_in + (size_t)l * D * WIN_LD, WIN_LD, 64 * kb, 32 * nb, wlp(ws, l, WO_IN), D, 32 * nb, scr, lane, W.g_mix + (size_t)l * D); return; } r -= TI_INA;
    if (r < TI_INB) { const int kb = r / 16, nb = r % 16; transpose_item(W.w_in + (size_t)l * D * WIN_LD, WIN_LD, 64 * kb, 3856 + 32 * nb, wlp(ws, l, WO_IN), D, C_OG + 32 * nb, scr, lane, W.g_mix + (size_t)l * D); return; } r -= TI_INB;
    if (r < TI_OUT) { const int kb = r / 64, nb = r % 64; transpose_item(W.w_out + (size_t)l * D * D, D, 64 * kb, 32 * nb, wlp(ws, l, WO_OUT), D, 32 * nb, scr, lane, nullptr); return; } r -= TI_OUT;
    if (r < TI_XQ) { const int kb = r / 16, nb = r % 16; transpose_item(W.xa_wq + (size_t)l * D * DXA, DXA, 64 * kb, 32 * nb, wlp(ws, l, WO_XQ), D, 32 * nb, scr, lane, W.g_xa + (size_t)l * D); return; } r -= TI_XQ;
    if (r < TI_XO) { const int kb = r / 64, nb = r % 64; transpose_item(W.xa_wo + (size_t)l * DXA * D, D, 64 * kb, 32 * nb, wlp(ws, l, WO_XO), DXA, 32 * nb, scr, lane, nullptr); return; } r -= TI_XO;
    if (r < TI_UP) { const int kb = r / 352, nb = r % 352; const int pn = nb >> 3, w8 = nb & 7, bj = w8 >> 2, cc = (w8 & 3) * 32;
        transpose_item(W.w_up + (size_t)l * D * NUP, NUP, 64 * kb, bj * DFF + 128 * pn + cc, wlp(ws, l, WO_UP), D, 32 * nb, scr, lane, W.g_ffn + (size_t)l * D); return; } r -= TI_UP;
    { const int kb = r / 64, nb = r % 64; transpose_item(W.w_dn + (size_t)l * DFF * D, D, 64 * kb, 32 * nb, wlp(ws, l, WO_DN), DFF, 32 * nb, scr, lane, nullptr); }
}
__device__ __forceinline__ void prologue_phase(const Ptrs& P, LAS unsigned char* lds, int gw, int ngw, int wave, int lane) {
    LAS float* scr = (LAS float*)(lds + RING_OFF + wave * 16384);
    { const WSrc W{P.in[3], P.in[10], P.in[13], P.in[15], P.in[17], P.in[20], P.in[2], P.in[11], P.in[16]};
      for (int it = gw; it < TI_LAYER_NOKV + NLAYER * TI_KV; it += ngw) {
          if (it < TI_LAYER_NOKV) { convert_layer_item(W, P.ws, 0, it, scr, lane); continue; }
          const int r2 = it - TI_LAYER_NOKV, l = r2 / TI_KV, r = r2 % TI_KV, kb = r / 32, nb = r % 32;
          transpose_item(P.in[14] + (size_t)l * D * 1024, 1024, 64 * kb, 32 * nb, (bf16*)(P.ws + WS_WKV), D, l * 1024 + 32 * nb, scr, lane, P.in[12] + (size_t)l * D);
      }
      if (gw == 0 && lane == 0) { unsigned long long* pp = (unsigned long long*)(P.ws + WS_PAR + PA_PTRS * 4);
          pp[0] = (unsigned long long)P.in[3]; pp[1] = (unsigned long long)P.in[10]; pp[2] = (unsigned long long)P.in[13]; pp[3] = (unsigned long long)P.in[15]; pp[4] = (unsigned long long)P.in[17]; pp[5] = (unsigned long long)P.in[20]; }
    }
    for (int it = gw; it < NLAYER * 32 * 8; it += ngw) {
        const int l = it >> 8, k = (((it >> 3) & 31) << 6) + lane, n0 = (it & 7) * 32;
        const float* src = P.in[3] + (size_t)l * D * WIN_LD + (size_t)k * WIN_LD + 3840;
        float a[16];
#pragma unroll
        for (int q = 0; q < 4; ++q) { const f32x4 t = *(const GAS f32x4*)(src + 4 * q); a[4 * q] = t.x; a[4 * q + 1] = t.y; a[4 * q + 2] = t.z; a[4 * q + 3] = t.w; }
        { const float gk = P.in[2][(size_t)l * D + k];
#pragma unroll
          for (int r = 0; r < 16; ++r) a[r] *= gk; }
        const float* w2 = P.in[7] + (size_t)l * 16 * 256;
        bf16* dst = wl(P, l, WO_IN) + (size_t)C_Z * D + k;
        for (int n = n0; n < n0 + 32; ++n) { float s = 0.f;
#pragma unroll
            for (int r = 0; r < 16; ++r) s += a[r] * w2[r * 256 + n];
            dst[(size_t)n * D] = (bf16)f2bf(s); }
    }
    { float* PA = (float*)(P.ws + WS_PAR); const int i0 = gw * 64 + lane, st = ngw * 64;
#define CPY(off, src, n) for (int i = i0; i < (n); i += st) PA[(off) + i] = (src)[i]
      CPY(PA_NMIX, P.in[2], NLAYER * D); CPY(PA_NXA, P.in[11], NLAYER * D); CPY(PA_NFFN, P.in[16], NLAYER * D); CPY(PA_FIN, P.in[21], D);
      CPY(PA_LAM, P.in[4], NLAYER * 128); CPY(PA_SUB, P.in[5], NLAYER * 64); CPY(PA_SINK, P.in[6], NLAYER * 16); CPY(PA_GB, P.in[8], NLAYER * 256); CPY(PA_GNG, P.in[9], NLAYER * 128);
      CPY(PA_CW, P.in[18], NLAYER * 3 * NUP); CPY(PA_CB, P.in[19], NLAYER * NUP);
#undef CPY
    }
    for (int r = gw; r < MROWS; r += ngw) rms_row_to_bf16(P.in[1] + (size_t)r * D, nullptr, (bf16*)(P.ws + WS_MEMN) + (size_t)r * D, nullptr, lane);
    for (int r = gw; r < T; r += ngw) {
        const GAS f32x4* xr = (const GAS f32x4*)(P.in[0] + (size_t)r * D) + lane; GAS v2u* o8 = (GAS v2u*)((bf16*)(P.ws + WS_HB) + (size_t)r * D) + lane;
        float s = 0.f;
#pragma unroll
        for (int j = 0; j < 8; ++j) { const f32x4 v = xr[64 * j]; s += (v.x * v.x + v.y * v.y) + (v.z * v.z + v.w * v.w); v2u w; w.x = pk2(v.x, v.y); w.y = pk2(v.z, v.w); o8[64 * j] = w; }
        s = wave_sum(s);
        if (lane < 8) ((float*)(P.ws + WS_SSQ))[(size_t)r * 8 + lane] = lane == 0 ? s : 0.f;
    }
}

__device__ __forceinline__ void gla_finish_row(const bf16* PROJ, const float* OGLA, bf16* MIX, const float* gng, int r, int lane) {
    const int hh = lane >> 4, sub = lane & 15;
    const float* src = OGLA + (size_t)r * 512 + hh * 128 + sub * 8;
    const f32x4 o0 = *(const GAS f32x4*)src, o1 = *(const GAS f32x4*)(src + 4);
    float ss = (o0.x * o0.x + o0.y * o0.y) + (o0.z * o0.z + o0.w * o0.w) + (o1.x * o1.x + o1.y * o1.y) + (o1.z * o1.z + o1.w * o1.w);
    ss += __shfl_xor(ss, 1); ss += __shfl_xor(ss, 2); ss += __shfl_xor(ss, 4); ss += __shfl_xor(ss, 8);
    const float rr = __builtin_amdgcn_rsqf(ss * (1.f / 128.f) + EPS);
    const v4u ogw = *(const GAS v4u*)(PROJ + (size_t)r * NPROJ + C_OG + hh * 128 + sub * 8);
    float og[8] = {bflo(ogw.x), bfhi(ogw.x), bflo(ogw.y), bfhi(ogw.y), bflo(ogw.z), bfhi(ogw.z), bflo(ogw.w), bfhi(ogw.w)};
    float ov[8] = {o0.x, o0.y, o0.z, o0.w, o1.x, o1.y, o1.z, o1.w};
    float y[8];
#pragma unroll
    for (int i = 0; i < 8; ++i) { const float sg = og[i] * __builtin_amdgcn_rcpf(1.0f + __builtin_amdgcn_exp2f(og[i] * -1.4426950408889634f)); y[i] = ov[i] * rr * gng[sub * 8 + i] * sg; }
    v4u w; w.x = pk2(y[0], y[1]); w.y = pk2(y[2], y[3]); w.z = pk2(y[4], y[5]); w.w = pk2(y[6], y[7]);
    *(GAS v4u*)(MIX + (size_t)r * D + M_GLA + hh * 128 + sub * 8) = w;
}
__device__ __forceinline__ void gla_finish_row2(const bf16* PROJ, const float* OGLA, bf16* MIX, const float* gng, int ra, int rb, int lane) {
    const int hh = lane >> 4, sub = lane & 15;
    const float* sa = OGLA + (size_t)ra * 512 + hh * 128 + sub * 8; const float* sb = OGLA + (size_t)rb * 512 + hh * 128 + sub * 8;
    const f32x4 oa0 = *(const GAS f32x4*)sa, oa1 = *(const GAS f32x4*)(sa + 4), ob0 = *(const GAS f32x4*)sb, ob1 = *(const GAS f32x4*)(sb + 4);
    const v4u ga = *(const GAS v4u*)(PROJ + (size_t)ra * NPROJ + C_OG + hh * 128 + sub * 8), gb = *(const GAS v4u*)(PROJ + (size_t)rb * NPROJ + C_OG + hh * 128 + sub * 8);
    const f32x4 n0 = *(const GAS f32x4*)(gng + sub * 8), n1 = *(const GAS f32x4*)(gng + sub * 8 + 4);
    const float gn[8] = {n0.x, n0.y, n0.z, n0.w, n1.x, n1.y, n1.z, n1.w};
#pragma unroll
    for (int k = 0; k < 2; ++k) { const f32x4 o0 = k ? ob0 : oa0, o1 = k ? ob1 : oa1; const v4u ogw = k ? gb : ga; const int r = k ? rb : ra;
        float ss = (o0.x * o0.x + o0.y * o0.y) + (o0.z * o0.z + o0.w * o0.w) + (o1.x * o1.x + o1.y * o1.y) + (o1.z * o1.z + o1.w * o1.w);
        ss += __shfl_xor(ss, 1); ss += __shfl_xor(ss, 2); ss += __shfl_xor(ss, 4); ss += __shfl_xor(ss, 8);
        const float rr = __builtin_amdgcn_rsqf(ss * (1.f / 128.f) + EPS);
        const float og[8] = {bflo(ogw.x), bfhi(ogw.x), bflo(ogw.y), bfhi(ogw.y), bflo(ogw.z), bfhi(ogw.z), bflo(ogw.w), bfhi(ogw.w)};
        const float ov[8] = {o0.x, o0.y, o0.z, o0.w, o1.x, o1.y, o1.z, o1.w};
        float y[8];
#pragma unroll
        for (int i = 0; i < 8; ++i) { const float sg = og[i] * __builtin_amdgcn_rcpf(1.0f + __builtin_amdgcn_exp2f(og[i] * -1.4426950408889634f)); y[i] = ov[i] * rr * gn[i] * sg; }
        v4u w; w.x = pk2(y[0], y[1]); w.y = pk2(y[2], y[3]); w.z = pk2(y[4], y[5]); w.w = pk2(y[6], y[7]);
        *(GAS v4u*)(MIX + (size_t)r * D + M_GLA + hh * 128 + sub * 8) = w; }
}


typedef short bf16x8 __attribute__((ext_vector_type(8)));
typedef float f32x16 __attribute__((ext_vector_type(16)));
#define MFMA32(a, b, c) __builtin_amdgcn_mfma_f32_32x32x16_bf16((a), (b), (c), 0, 0, 0)
constexpr float LOG2E = 1.4426950408889634f;
__device__ __forceinline__ bf16x8 ldf(const bf16* p) { return *(const GAS bf16x8*)p; }
typedef float f32x2_t __attribute__((ext_vector_type(2))); typedef __bf16 bf16x2_t __attribute__((ext_vector_type(2)));
__device__ __forceinline__ unsigned cvtpk(float lo, float hi) { f32x2_t v = {lo, hi}; bf16x2_t b = __builtin_convertvector(v, bf16x2_t); return __builtin_bit_cast(unsigned, b); }
__device__ __forceinline__ void acc2frag(const f32x16& x, bf16x8& f0, bf16x8& f1) {
    v4u a, b;
    a.x = cvtpk(x[0], x[1]); a.y = cvtpk(x[2], x[3]); a.z = cvtpk(x[4], x[5]); a.w = cvtpk(x[6], x[7]);
    b.x = cvtpk(x[8], x[9]); b.y = cvtpk(x[10], x[11]); b.z = cvtpk(x[12], x[13]); b.w = cvtpk(x[14], x[15]);
    f0 = __builtin_bit_cast(bf16x8, a); f1 = __builtin_bit_cast(bf16x8, b);
}
typedef unsigned u32x2p __attribute__((ext_vector_type(2)));
__device__ __forceinline__ void store_pair16(bf16* orow, int h, int k, v2u a, v2u b) {
    const u32x2p rx = __builtin_amdgcn_permlane32_swap(a.x, b.x, false, false), ry = __builtin_amdgcn_permlane32_swap(a.y, b.y, false, false);
    v4u w; w.x = rx[0]; w.y = ry[0]; w.z = rx[1]; w.w = ry[1];
    *(GAS v4u*)(orow + 8 * (k + h)) = w;
}
__device__ __forceinline__ f32x16 zero16() { f32x16 z;
#pragma unroll
    for (int i = 0; i < 16; ++i) z[i] = 0.f;
    return z; }
__device__ __forceinline__ void make_idf(bf16x8 (&idf)[2], int lane) {
    const int c = lane & 31, h = lane >> 5;
#pragma unroll
    for (int q = 0; q < 2; ++q)
#pragma unroll
        for (int j = 0; j < 8; ++j) idf[q][j] = ((16 * q + 8 * h + j) == c) ? (short)0x3F80 : (short)0;
}
#define SROW(i, h) (((i) & 3) + 8 * ((i) >> 2) + 4 * (h))


#define SOFTMAX_LAZY(x, xoff, mref, lrun, OT, NV, pf0, pf1) do { \
    float tm_ = fmaxf(fmaxf(x[0], x[1]), fmaxf(x[2], x[3])); \
    _Pragma("unroll") for (int i_ = 4; i_ < 16; i_ += 4) tm_ = fmaxf(tm_, fmaxf(fmaxf(x[i_], x[i_ + 1]), fmaxf(x[i_ + 2], x[i_ + 3]))); \
    if (__any(tm_ > 6.0f)) { \
        tm_ = fmaxf(tm_, __shfl_xor(tm_, 32)); \
        const float d_ = fmaxf(tm_, 0.f); const float corr_ = __builtin_amdgcn_exp2f(-d_); \
        mref += d_; xoff -= d_; lrun *= corr_; \
        _Pragma("unroll") for (int i_ = 0; i_ < 16; ++i_) x[i_] -= d_; \
        _Pragma("unroll") for (int v_ = 0; v_ < (NV); ++v_) OT[v_] = OT[v_] * corr_; \
    } \
    f32x16 p_; float ps_ = 0.f; \
    _Pragma("unroll") for (int i_ = 0; i_ < 16; ++i_) { p_[i_] = __builtin_amdgcn_exp2f(x[i_]); ps_ += p_[i_]; } \
    lrun += ps_; \
    acc2frag(p_, pf0, pf1); } while (0)


constexpr int DRING_STAGES = 8, DRING_STAGE_BYTES = 8192, DRAW_OFF = 65536, DRAW_BYTES = 4096;
#define MIXW_WAIT_V(n) asm volatile("s_waitcnt vmcnt(" #n ")" ::: "memory")
__device__ __forceinline__ void diff_wg_item(LAS unsigned char* ring, const bf16* PROJ, const bf16* DKV, bf16* MIX, int b, int hd, int QB, float lam_full, float one_m_li, const float* subg, int lane, int wave) {
    const int tl = lane & 31, h = lane >> 5;
    const int qb = QB * 8 + wave, ktop = QB * 8 + 7;
    const size_t row0 = (size_t)b * SEQ;
    const bf16* qrow = PROJ + (row0 + qb * 32 + tl) * NPROJ + C_DQ + hd * 64 + 8 * h;
    bf16x8 qf[2][2];
#pragma unroll
    for (int m = 0; m < 2; ++m)
#pragma unroll
        for (int q = 0; q < 2; ++q) qf[m][q] = ldf(qrow + m * 32 + 16 * q);
    bf16x8 idf[2]; make_idf(idf, lane);
    const float slope2 = exp2f(-(float)(hd + 1)) * LOG2E, c1 = 0.17677669529663687f * LOG2E;
    float cst[16];
#pragma unroll
    for (int i = 0; i < 16; ++i) cst[i] = slope2 * (float)((i & 3) + 8 * (i >> 2));
    f32x16 O0[2], O1[2];
    O0[0] = zero16(); O0[1] = zero16(); O1[0] = zero16(); O1[1] = zero16();
    float m0 = 0.f, m1 = 0.f, l0 = 0.f, l1 = 0.f;
    float off0 = slope2 * (float)(4 * h - tl) - m0, off1 = off0;
    const float dstep = -32.f * slope2;
    const char* gsrc = (const char*)(DKV + dkv_off(b, hd, 0, wave)) + lane * 16;
    LAS unsigned char* dmy = ring + (wave < 4 ? wave * 1024 : DRAW_OFF + (wave - 4) * 1024);
    const int dstride = wave < 4 ? DRING_STAGE_BYTES : DRAW_BYTES;
    const LAS unsigned char* rd = ring + lane * 16;
#define DIFF_ISSUE(KT) __builtin_amdgcn_global_load_lds((const unsigned*)(gsrc + (size_t)(KT) * 8192), (LAS unsigned*)(dmy + ((KT) & 7) * dstride), 16, 0, 0)
#define DIFF_VT(T) do { if ((wave & 6) == (((T) & 3) << 1)) { const int vt_ = wave & 1; const LAS unsigned char* rp = rd + DRAW_OFF + ((T) & 7) * DRAW_BYTES + vt_ * 2048; \
        f32x16 vc = MFMA32(*(const LAS bf16x8*)(rp), idf[0], zero16()); vc = MFMA32(*(const LAS bf16x8*)(rp + 1024), idf[1], vc); bf16x8 a0, a1; acc2frag(vc, a0, a1); \
        LAS unsigned char* wp = ring + ((T) & 7) * DRING_STAGE_BYTES + 4096 + vt_ * 2048 + lane * 16; *(LAS bf16x8*)(wp) = a0; *(LAS bf16x8*)(wp + 1024) = a1; } } while (0)
#define DIFFW_WAITN(n) asm volatile("s_waitcnt vmcnt(" #n ") lgkmcnt(0)" ::: "memory")
#define DIFFW_SYNC() do { if (kt >= 6) DIFFW_WAITN(5); else if (kt == 5) DIFFW_WAITN(4); else if (kt == 4) DIFFW_WAITN(3); else if (kt == 3) DIFFW_WAITN(2); else if (kt == 2) DIFFW_WAITN(1); else DIFFW_WAITN(0); \
        __builtin_amdgcn_s_barrier(); if (kt >= 7) DIFF_ISSUE(kt - 7); if (kt >= 1) DIFF_VT(kt - 1); } while (0)
#define DIFFW_SCORES(KT, D0, D1) do { const LAS unsigned char* spk = rd + ((KT) & 7) * DRING_STAGE_BYTES; \
        const bf16x8 k00 = *(const LAS bf16x8*)(spk), k01 = *(const LAS bf16x8*)(spk + 1024), k10 = *(const LAS bf16x8*)(spk + 2048), k11 = *(const LAS bf16x8*)(spk + 3072); \
        D0 = MFMA32(k00, qf[0][0], zero16()); D1 = MFMA32(k10, qf[1][0], zero16()); D0 = MFMA32(k01, qf[0][1], D0); D1 = MFMA32(k11, qf[1][1], D1); } while (0)
#define MX3(a, b, c) __builtin_fmaxf(__builtin_fmaxf((a), (b)), (c))
#define MAX16(v) __builtin_fmaxf(MX3(MX3(MX3(v[0], v[1], v[2]), v[3], v[4]), MX3(v[5], v[6], v[7]), MX3(v[8], v[9], v[10])), MX3(MX3(v[11], v[12], v[13]), v[14], v[15]))
#define DIFFW_TILE(MASKED) do { \
        f32x16 n0, n1; DIFFW_SCORES(kt - 1, n0, n1);                   \
        const float bnd0 = MAX16(sA0) * c1 + (cmax + off0), bnd1 = MAX16(sA1) * c1 + (cmax + off1); \
        if ((MASKED) || __any(fmaxf(bnd0, bnd1) > -60.0f)) { \
        const LAS unsigned char* spv = rd + (kt & 7) * DRING_STAGE_BYTES + 4096; \
        const bf16x8 a00 = *(const LAS bf16x8*)(spv), a01 = *(const LAS bf16x8*)(spv + 1024), a10 = *(const LAS bf16x8*)(spv + 2048), a11 = *(const LAS bf16x8*)(spv + 3072); \
        float x0[16], x1[16]; \
        _Pragma("unroll") for (int i = 0; i < 16; ++i) { const float t0 = sA0[i] * c1 + cst[i], t1 = sA1[i] * c1 + cst[i]; x0[i] = t0 + off0; x1[i] = t1 + off1; \
            if ((MASKED) && SROW(i, h) > tl) { x0[i] = -1e30f; x1[i] = -1e30f; } } \
        if (__builtin_expect(__any(fmaxf(bnd0, bnd1) > 6.0f), 0)) { \
            float tm0 = MAX16(x0), tm1 = MAX16(x1); \
            if (__any(fmaxf(tm0, tm1) > 6.0f)) { \
            tm0 = fmaxf(tm0, __shfl_xor(tm0, 32)); tm1 = fmaxf(tm1, __shfl_xor(tm1, 32)); \
            const float d0 = fmaxf(tm0, 0.f), d1 = fmaxf(tm1, 0.f); const float cr0 = __builtin_amdgcn_exp2f(-d0), cr1 = __builtin_amdgcn_exp2f(-d1); \
            m0 += d0; m1 += d1; off0 -= d0; off1 -= d1; l0 *= cr0; l1 *= cr1; \
            _Pragma("unroll") for (int i = 0; i < 16; ++i) { x0[i] -= d0; x1[i] -= d1; } \
            O0[0] = O0[0] * cr0; O0[1] = O0[1] * cr0; O1[0] = O1[0] * cr1; O1[1] = O1[1] * cr1; } \
        } \
        f32x16 p0, p1; float ps0 = 0.f, ps1 = 0.f; \
        _Pragma("unroll") for (int i = 0; i < 16; ++i) { p0[i] = __builtin_amdgcn_exp2f(x0[i]); p1[i] = __builtin_amdgcn_exp2f(x1[i]); ps0 += p0[i]; ps1 += p1[i]; } \
        l0 += ps0; l1 += ps1; \
        bf16x8 pf00, pf01, pf10, pf11; \
        acc2frag(p0, pf00, pf01); acc2frag(p1, pf10, pf11); \
        O0[0] = MFMA32(a00, pf00, O0[0]); O0[1] = MFMA32(a10, pf00, O0[1]); O1[0] = MFMA32(a00, pf10, O1[0]); O1[1] = MFMA32(a10, pf10, O1[1]); \
        O0[0] = MFMA32(a01, pf01, O0[0]); O0[1] = MFMA32(a11, pf01, O0[1]); O1[0] = MFMA32(a01, pf11, O1[0]); O1[1] = MFMA32(a11, pf11, O1[1]); \
        } \
        sA0 = n0; sA1 = n1; off0 += dstep; off1 += dstep; } while (0)
    const float cmax = 27.f * slope2;
    DIFF_ISSUE(ktop); DIFF_ISSUE(ktop - 1); DIFF_ISSUE(ktop - 2); DIFF_ISSUE(ktop - 3); DIFF_ISSUE(ktop - 4); DIFF_ISSUE(ktop - 5);
    f32x16 sA0, sA1;
    int kt = ktop + 1;
    for (; kt > qb + 1; --kt) DIFFW_SYNC();
    { DIFFW_SYNC(); DIFFW_SCORES(qb, sA0, sA1); --kt; }
    { DIFFW_SYNC(); DIFFW_TILE(true); }
    for (kt = qb - 1; kt >= 0; --kt) { DIFFW_SYNC(); DIFFW_TILE(false); }
#undef DIFFW_SYNC
#undef DIFFW_WAITN
#undef DIFFW_SCORES
#undef DIFFW_TILE
#undef MAX16
#undef MX3
#undef DIFF_ISSUE
#undef DIFF_VT
    l0 += __shfl_xor(l0, 32); l1 += __shfl_xor(l1, 32);
    const float i0 = 1.0f / l0, i1 = lam_full / l1;
    float ss = 0.f;
#pragma unroll
    for (int vt = 0; vt < 2; ++vt)
#pragma unroll
        for (int i = 0; i < 16; ++i) { const float v = O0[vt][i] * i0 - O1[vt][i] * i1; O0[vt][i] = v; ss += v * v; }
    ss += __shfl_xor(ss, 32);
    const float r = one_m_li / sqrtf(ss * (1.f / 64.f) + EPS);
    bf16* orow = MIX + (row0 + qb * 32 + tl) * D + M_DIFF + hd * 64;
#pragma unroll
    for (int vt = 0; vt < 2; ++vt)
#pragma unroll
        for (int k = 0; k < 4; k += 2) { v2u w[2];
#pragma unroll
            for (int e = 0; e < 2; ++e) { const int v0 = 32 * vt + 8 * (k + e) + 4 * h; const f32x4 g = *(const GAS f32x4*)(subg + v0);
                w[e].x = cvtpk(O0[vt][4 * (k + e)] * r * g.x, O0[vt][4 * (k + e) + 1] * r * g.y); w[e].y = cvtpk(O0[vt][4 * (k + e) + 2] * r * g.z, O0[vt][4 * (k + e) + 3] * r * g.w); }
            store_pair16(orow + 32 * vt, h, k, w[0], w[1]); }
}


constexpr int SW_STAGE = 8192, SW_RAW_OFF = 65536, SW_RAW = 4096;
__device__ __forceinline__ void swa_wg_item(LAS unsigned char* ring, const bf16* PROJ, const bf16* SKV, bf16* MIX, int b, int g, int qb0, float sink, int lane, int wave) {
    const int tl = lane & 31, h = lane >> 5, hq = g * 8 + wave, qbl = qb0 + 7;
    const size_t row0 = (size_t)b * SEQ;
    bf16x8 idf[2]; make_idf(idf, lane);
    const float slope2 = exp2f(-0.5f * (float)(hq + 1)) * LOG2E, c1 = 0.125f * LOG2E;
    float cst[16];
#pragma unroll
    for (int i = 0; i < 16; ++i) cst[i] = slope2 * (float)((i & 3) + 8 * (i >> 2));
    const float dstep = -32.f * slope2;
    const char* gsrc = (const char*)(SKV + skv_off(b, g, 0, wave)) + lane * 16;
    LAS unsigned char* dmy = ring + (wave < 4 ? wave * 1024 : SW_RAW_OFF + (wave - 4) * 1024);
    const int dstride = wave < 4 ? SW_STAGE : SW_RAW;
    const LAS unsigned char* rd = ring + lane * 16;
#define SWA_ISSUE(T) __builtin_amdgcn_global_load_lds((const unsigned*)(gsrc + (size_t)(T) * 8192), (LAS unsigned*)(dmy + ((T) & 7) * dstride), 16, 0, 0)
#define SWA_VT(T) do { if ((wave & 6) == (((T) & 3) << 1)) { const int vt_ = wave & 1; const LAS unsigned char* rp = rd + SW_RAW_OFF + ((T) & 7) * SW_RAW + vt_ * 2048; \
        f32x16 vc = MFMA32(*(const LAS bf16x8*)(rp), idf[0], zero16()); vc = MFMA32(*(const LAS bf16x8*)(rp + 1024), idf[1], vc); bf16x8 a0, a1; acc2frag(vc, a0, a1); \
        LAS unsigned char* wp = ring + ((T) & 7) * SW_STAGE + 4096 + vt_ * 2048 + lane * 16; *(LAS bf16x8*)(wp) = a0; *(LAS bf16x8*)(wp + 1024) = a1; } } while (0)
    const int t0 = qb0 >= 4 ? qb0 - 4 : 0;
    for (int t = t0; t <= qb0 + 1; ++t) SWA_ISSUE(t);
    asm volatile("" ::: "memory");
    bf16x8 qn[4];
    { const bf16* qrow = PROJ + (row0 + qb0 * 32 + tl) * NPROJ + C_SQ + hq * 64 + 8 * h;
#pragma unroll
      for (int q = 0; q < 4; ++q) qn[q] = ldf(qrow + 16 * q); }
    asm volatile("s_waitcnt vmcnt(0)" ::: "memory");
    __builtin_amdgcn_s_barrier();
    for (int t = t0; t <= qb0; ++t) SWA_VT(t);
    for (int qb = qb0; qb <= qbl; ++qb) {
        bf16x8 qf[4];
#pragma unroll
        for (int q = 0; q < 4; ++q) { qf[q] = qn[q]; asm volatile("" :: "v"(qf[q])); }
        asm volatile("s_waitcnt lgkmcnt(0)" ::: "memory");
        __builtin_amdgcn_s_barrier();
        if (qb + 2 <= qbl) SWA_ISSUE(qb + 2);
        asm volatile("" ::: "memory");
        if (qb < qbl) { const bf16* qrow = PROJ + (row0 + (qb + 1) * 32 + tl) * NPROJ + C_SQ + hq * 64 + 8 * h;
#pragma unroll
            for (int q = 0; q < 4; ++q) qn[q] = ldf(qrow + 16 * q);
            SWA_VT(qb + 1); }
        f32x16 O[2]; O[0] = zero16(); O[1] = zero16();
        float mr = sink * LOG2E, lr = (h == 0) ? 1.f : 0.f;
        float off = slope2 * (float)(4 * h - tl) - mr;
        const int kt0 = qb >= 4 ? qb - 4 : 0;
#define SWAW_TILE(MODE) do { \
            const LAS unsigned char* sp = rd + (kt & 7) * SW_STAGE; \
            f32x16 sc = MFMA32(*(const LAS bf16x8*)(sp), qf[0], zero16()); \
            _Pragma("unroll") for (int q = 1; q < 4; ++q) sc = MFMA32(*(const LAS bf16x8*)(sp + q * 1024), qf[q], sc); \
            const bf16x8 va0 = *(const LAS bf16x8*)(sp + 4096), va1 = *(const LAS bf16x8*)(sp + 5120), vb0 = *(const LAS bf16x8*)(sp + 6144), vb1 = *(const LAS bf16x8*)(sp + 7168); \
            float x[16]; \
            _Pragma("unroll") for (int i = 0; i < 16; ++i) { x[i] = (sc[i] * c1 + cst[i]) + off; if (((MODE) == 1 && SROW(i, h) > tl) || ((MODE) == 2 && SROW(i, h) <= tl)) x[i] = -1e30f; } \
            bf16x8 pf0, pf1; SOFTMAX_LAZY(x, off, mr, lr, O, 2, pf0, pf1); \
            O[0] = MFMA32(va0, pf0, O[0]); O[1] = MFMA32(vb0, pf0, O[1]); O[0] = MFMA32(va1, pf1, O[0]); O[1] = MFMA32(vb1, pf1, O[1]); \
            off += dstep; } while (0)
        int kt = qb;
        SWAW_TILE(1);
        for (kt = qb - 1; kt > qb - 4 && kt >= 0; --kt) SWAW_TILE(0);
        if (qb >= 4) { kt = qb - 4; SWAW_TILE(2); }
#undef SWAW_TILE
        lr += __shfl_xor(lr, 32);
        const float il = 1.0f / lr;
        bf16* orow = MIX + (row0 + qb * 32 + tl) * D + M_SWA + hq * 64;
#pragma unroll
        for (int vt = 0; vt < 2; ++vt)
#pragma unroll
            for (int k = 0; k < 4; k += 2) { v2u w[2];
#pragma unroll
                for (int e = 0; e < 2; ++e) { w[e].x = cvtpk(O[vt][4 * (k + e)] * il, O[vt][4 * (k + e) + 1] * il); w[e].y = cvtpk(O[vt][4 * (k + e) + 2] * il, O[vt][4 * (k + e) + 3] * il); }
                store_pair16(orow + 32 * vt, h, k, w[0], w[1]); }
    }
#undef SWA_ISSUE
#undef SWA_VT
}


__device__ __forceinline__ void xatt_wg_item(LAS unsigned char* ring, const bf16* QXA, const bf16* KVMEM, bf16* OXA, int layer, int b, int hd, int part, int lane, int wave) {
    const int tl = lane & 31, h = lane >> 5;
    const char* gsrc = (const char*)(KVMEM + xkv_off(layer, b, hd, 0, 0)) + wave * 1024 + lane * 16;
    LAS unsigned char* dmy = ring + wave * 1024;
#pragma unroll
    for (int i = 0; i < 16; ++i) __builtin_amdgcn_global_load_lds((const unsigned*)(gsrc + i * 8192), (LAS unsigned*)(dmy + i * 8192), 16, 0, 0);
    asm volatile("" ::: "memory");
    bf16x8 idf[2]; make_idf(idf, lane);
    const LAS unsigned char* rd = ring + lane * 16;
    asm volatile("s_waitcnt vmcnt(0)" ::: "memory");
    __builtin_amdgcn_s_barrier();
#pragma unroll
    for (int jj = 0; jj < 4; ++jj) { const int j = wave + 8 * jj, kt = j >> 2, vt = j & 3;
        LAS unsigned char* fp = ring + kt * 16384 + (8 + 2 * vt) * 1024 + lane * 16;
        f32x16 vc = MFMA32(*(const LAS bf16x8*)(fp), idf[0], zero16()); vc = MFMA32(*(const LAS bf16x8*)(fp + 1024), idf[1], vc);
        bf16x8 a0, a1; acc2frag(vc, a0, a1); *(LAS bf16x8*)(fp) = a0; *(LAS bf16x8*)(fp + 1024) = a1; }
    asm volatile("s_waitcnt lgkmcnt(0)" ::: "memory");
    __builtin_amdgcn_s_barrier();
    const float c1 = 0.08838834764831845f * LOG2E;
    for (int i2 = 0; i2 < 2; ++i2) {
        const int qb = part * 16 + i2 * 8 + wave;
        const bf16* qrow = QXA + ((size_t)b * SEQ + qb * 32 + tl) * DXA + hd * 128 + 8 * h;
        bf16x8 qf[8];
#pragma unroll
        for (int q = 0; q < 8; ++q) qf[q] = ldf(qrow + 16 * q);
        f32x16 O[4];
#pragma unroll
        for (int vt = 0; vt < 4; ++vt) O[vt] = zero16();
        float mr = 0.f, lr = 0.f, off = 0.f;
        for (int kt = 0; kt < NMEM / 32; ++kt) {
            const LAS unsigned char* kp = rd + kt * 16384;
            f32x16 s = MFMA32(*(const LAS bf16x8*)(kp), qf[0], zero16());
#pragma unroll
            for (int q = 1; q < 8; ++q) s = MFMA32(*(const LAS bf16x8*)(kp + q * 1024), qf[q], s);
            float x[16];
#pragma unroll
            for (int i = 0; i < 16; ++i) x[i] = s[i] * c1 + off;
            bf16x8 pf0, pf1; SOFTMAX_LAZY(x, off, mr, lr, O, 4, pf0, pf1);
#pragma unroll
            for (int vt = 0; vt < 4; ++vt) { O[vt] = MFMA32(*(const LAS bf16x8*)(kp + (8 + 2 * vt) * 1024), pf0, O[vt]); O[vt] = MFMA32(*(const LAS bf16x8*)(kp + (9 + 2 * vt) * 1024), pf1, O[vt]); }
        }
        lr += __shfl_xor(lr, 32);
        const float il = 1.0f / lr;
        bf16* orow = OXA + ((size_t)b * SEQ + qb * 32 + tl) * DXA + hd * 128;
#pragma unroll
        for (int vt = 0; vt < 4; ++vt)
#pragma unroll
            for (int k = 0; k < 4; k += 2) { v2u w[2];
#pragma unroll
                for (int e = 0; e < 2; ++e) { w[e].x = cvtpk(O[vt][4 * (k + e)] * il, O[vt][4 * (k + e) + 1] * il); w[e].y = cvtpk(O[vt][4 * (k + e) + 2] * il, O[vt][4 * (k + e) + 3] * il); }
                store_pair16(orow + 32 * vt, h, k, w[0], w[1]); }
    }
}

__device__ __forceinline__ size_t gla_frag_off(int b, int hd, int c, int R, int q, int lane) { return ((((((size_t)b * 4 + hd) * 32 + c) * 2 + R) * 4 + q) * 64 + lane) * 8; }
__device__ __forceinline__ void gla_prep_item(const bf16* PROJ, unsigned char* ws, int b, int hd, int c, const float* gate_b, int lane) {
    const int tl = lane & 31, h = lane >> 5;
    bf16* GQD = (bf16*)(ws + WS_GQD); bf16* GKI = (bf16*)(ws + WS_GKI); float* GEB = (float*)(ws + WS_GEB);
    const bf16* cbR[2]; cbR[0] = PROJ + ((size_t)b * SEQ + 64 * c + tl) * NPROJ; cbR[1] = cbR[0] + (size_t)32 * NPROJ;
    const float* gb = gate_b + hd * 64 + 4 * h;
    v2u zl[4][2], zh[4][2], ql[4][2], qh[4][2], kl[4][2], kh[4][2]; f32x4 b0[4], b1[4];
#pragma unroll
    for (int q = 0; q < 4; ++q) { b0[q] = *(const GAS f32x4*)(gb + 16 * q); b1[q] = *(const GAS f32x4*)(gb + 16 * q + 8);
#pragma unroll
        for (int R = 0; R < 2; ++R) { const bf16* rp = cbR[R] + C_Z + hd * 64 + 16 * q + 4 * h; const bf16* rq = cbR[R] + C_GQ + hd * 64 + 16 * q + 4 * h; const bf16* rk = cbR[R] + C_GK + hd * 64 + 16 * q + 4 * h;
            zl[q][R] = *(const GAS v2u*)rp; zh[q][R] = *(const GAS v2u*)(rp + 8); ql[q][R] = *(const GAS v2u*)rq; qh[q][R] = *(const GAS v2u*)(rq + 8); kl[q][R] = *(const GAS v2u*)rk; kh[q][R] = *(const GAS v2u*)(rk + 8); } }
#pragma unroll
    for (int q = 0; q < 4; ++q) {
        float bc[2][8];
        const float bias[8] = {b0[q].x, b0[q].y, b0[q].z, b0[q].w, b1[q].x, b1[q].y, b1[q].z, b1[q].w};
#pragma unroll
        for (int R = 0; R < 2; ++R) {
            const v2u lo = zl[q][R], hi = zh[q][R];
            const float z[8] = {bflo(lo.x), bfhi(lo.x), bflo(lo.y), bfhi(lo.y), bflo(hi.x), bfhi(hi.x), bflo(hi.y), bfhi(hi.y)};
#pragma unroll
            for (int j = 0; j < 8; ++j) { const float zz = z[j] + bias[j];
                bc[R][j] = (fminf(zz, 0.f) * LOG2E - __builtin_amdgcn_logf(1.0f + __builtin_amdgcn_exp2f(-fabsf(zz) * LOG2E))) * (1.f / 16.f); }
        }
#pragma unroll
        for (int dl = 1; dl < 32; dl <<= 1)
#pragma unroll
            for (int R = 0; R < 2; ++R)
#pragma unroll
                for (int j = 0; j < 8; ++j) { const float t = __shfl_up(bc[R][j], dl, 32); if (tl >= dl) bc[R][j] += t; }
        float eb[8];
#pragma unroll
        for (int j = 0; j < 8; ++j) { bc[1][j] += __shfl(bc[0][j], 31, 32); eb[j] = __builtin_amdgcn_exp2f(__shfl(bc[1][j], 31, 32)); }
        if (tl == 0) { float* e = GEB + ((((size_t)b * 4 + hd) * 32 + c) * 4 + q) * 16 + h * 8;
            *(GAS f32x4*)e = (f32x4){eb[0], eb[1], eb[2], eb[3]}; *(GAS f32x4*)(e + 4) = (f32x4){eb[4], eb[5], eb[6], eb[7]}; }
#pragma unroll
        for (int R = 0; R < 2; ++R) {
            const v2u ql_ = ql[q][R], qh_ = qh[q][R], kl_ = kl[q][R], kh_ = kh[q][R];
            const float qv[8] = {bflo(ql_.x), bfhi(ql_.x), bflo(ql_.y), bfhi(ql_.y), bflo(qh_.x), bfhi(qh_.x), bflo(qh_.y), bfhi(qh_.y)};
            const float kv[8] = {bflo(kl_.x), bfhi(kl_.x), bflo(kl_.y), bfhi(kl_.y), bflo(kh_.x), bfhi(kh_.x), bflo(kh_.y), bfhi(kh_.y)};
            float qq[8], kk[8];
#pragma unroll
            for (int j = 0; j < 8; ++j) { qq[j] = qv[j] * 0.125f * __builtin_amdgcn_exp2f(bc[R][j]); kk[j] = kv[j] * __builtin_amdgcn_exp2f(-bc[R][j]); }
            v4u wq, wk;
            wq.x = cvtpk(qq[0], qq[1]); wq.y = cvtpk(qq[2], qq[3]); wq.z = cvtpk(qq[4], qq[5]); wq.w = cvtpk(qq[6], qq[7]);
            wk.x = cvtpk(kk[0], kk[1]); wk.y = cvtpk(kk[2], kk[3]); wk.z = cvtpk(kk[4], kk[5]); wk.w = cvtpk(kk[6], kk[7]);
            const size_t fo = gla_frag_off(b, hd, c, R, q, lane);
            *(GAS v4u*)(GQD + fo) = wq; *(GAS v4u*)(GKI + fo) = wk;
        }
    }
}
__device__ __forceinline__ void gla_fast_item(const bf16* PROJ, const unsigned char* ws, float* OGLA, int b, int hd, int vq, int lane) {
    const int tl = lane & 31, h = lane >> 5;
    const bf16* GQD = (const bf16*)(ws + WS_GQD); const bf16* GKI = (const bf16*)(ws + WS_GKI); const float* GEB = (const float*)(ws + WS_GEB);
    bf16x8 idf[2]; make_idf(idf, lane);
    bf16x8 idp[2];
#pragma unroll
    for (int q = 0; q < 2; ++q)
#pragma unroll
        for (int j = 0; j < 8; ++j) idp[q][j] = ((16 * q + 8 * (j >> 2) + 4 * h + (j & 3)) == tl) ? (short)0x3F80 : (short)0;
    f32x16 S[2]; S[0] = zero16(); S[1] = zero16();
    const bf16* vbase = (const bf16*)(ws + WS_GVF) + gvf_off(b, hd, 0, vq, 0) + lane * 8;
    for (int c = 0; c < SEQ / 64; ++c) {
        bf16x8 qd[2][4], ki[2][4];
        { const GAS bf16* fq_ = (const GAS bf16*)(GQD + gla_frag_off(b, hd, c, 0, 0, lane)); const GAS bf16* fk_ = (const GAS bf16*)(GKI + gla_frag_off(b, hd, c, 0, 0, lane));
          asm volatile("" : "+v"(fq_), "+v"(fk_));
#pragma unroll
          for (int R = 0; R < 2; ++R)
#pragma unroll
              for (int q = 0; q < 4; ++q) { qd[R][q] = *(const GAS bf16x8*)(fq_ + (R * 4 + q) * 512); ki[R][q] = *(const GAS bf16x8*)(fk_ + (R * 4 + q) * 512); } }
        f32x16 o[2]; o[0] = zero16(); o[1] = zero16();
#pragma unroll
        for (int dt = 0; dt < 2; ++dt) { bf16x8 sb0, sb1; acc2frag(S[dt], sb0, sb1);
#pragma unroll
            for (int tt = 0; tt < 2; ++tt) { o[tt] = MFMA32(qd[tt][2 * dt], sb0, o[tt]); o[tt] = MFMA32(qd[tt][2 * dt + 1], sb1, o[tt]); } }
        bf16x8 vb[2][2];
#pragma unroll
        for (int ts = 0; ts < 2; ++ts) { const bf16* vp = vbase + (size_t)(2 * c + ts) * 4096;
            f32x16 vc = MFMA32(ldf(vp), idf[0], zero16()); vc = MFMA32(ldf(vp + 512), idf[1], vc); acc2frag(vc, vb[ts][0], vb[ts][1]); }
#pragma unroll
        for (int ts = 0; ts < 2; ++ts)
#pragma unroll
            for (int tt = ts; tt < 2; ++tt) {
                f32x16 at = MFMA32(ki[ts][0], qd[tt][0], zero16());
#pragma unroll
                for (int q = 1; q < 4; ++q) at = MFMA32(ki[ts][q], qd[tt][q], at);
                if (ts == tt) {
#pragma unroll
                    for (int i = 0; i < 16; ++i) if (SROW(i, h) > tl) at[i] = 0.f;
                }
                bf16x8 x0, x1; acc2frag(at, x0, x1);
                o[tt] = MFMA32(x0, vb[ts][0], o[tt]); o[tt] = MFMA32(x1, vb[ts][1], o[tt]);
            }
        const float* ebp = GEB + (((size_t)b * 4 + hd) * 32 + c) * 64 + h * 8;
#pragma unroll
        for (int dt = 0; dt < 2; ++dt) {
#pragma unroll
            for (int ts = 0; ts < 2; ++ts) { f32x16 kc = MFMA32(ki[ts][2 * dt], idp[0], zero16()); kc = MFMA32(ki[ts][2 * dt + 1], idp[1], kc);
                bf16x8 ka0, ka1; acc2frag(kc, ka0, ka1); S[dt] = MFMA32(ka0, vb[ts][0], S[dt]); S[dt] = MFMA32(ka1, vb[ts][1], S[dt]); }
#pragma unroll
            for (int g2 = 0; g2 < 2; ++g2) { const f32x4 e0 = *(const GAS f32x4*)(ebp + (2 * dt + g2) * 16), e1 = *(const GAS f32x4*)(ebp + (2 * dt + g2) * 16 + 4);
                S[dt][8 * g2 + 0] *= e0.x; S[dt][8 * g2 + 1] *= e0.y; S[dt][8 * g2 + 2] *= e0.z; S[dt][8 * g2 + 3] *= e0.w;
                S[dt][8 * g2 + 4] *= e1.x; S[dt][8 * g2 + 5] *= e1.y; S[dt][8 * g2 + 6] *= e1.z; S[dt][8 * g2 + 7] *= e1.w; }
        }
#pragma unroll
        for (int tt = 0; tt < 2; ++tt)
#pragma unroll
            for (int i = 0; i < 16; ++i) OGLA[((size_t)b * SEQ + 64 * c + 32 * tt + SROW(i, h)) * 512 + hd * 128 + 32 * vq + tl] = o[tt][i];
    }
}

constexpr int CW_QW = 32768;
__device__ __forceinline__ void mix_wg_phase(LAS unsigned char* lds, unsigned char* ws, int qslot, int layer, int lane, int wave, int bx, int G, int parts = 7) {
    const bf16* PROJ = (const bf16*)(ws + WS_PROJ); bf16* MIX = (bf16*)(ws + WS_XN); float* OGLA = (float*)(ws + WS_OGLA); const float* PA = (const float*)(ws + WS_PAR);
    if (parts & 1) for (int idx = bx * NWAVES + wave; idx < NB * 16; idx += G * NWAVES) { int ln = lane; asm volatile("" : "+v"(ln)); gla_fast_item(PROJ, ws, OGLA, idx >> 4, (idx >> 2) & 3, idx & 3, ln); }
    asm volatile("" ::: "memory");
    const float li = 0.8f - 0.6f * expf(-0.3f * (float)layer);
    float lam_full;
    { int ln = lane; asm volatile("" : "+v"(ln));
      const float* lam = PA + PA_LAM + layer * 128;
      const float pa = lam[ln], pb = lam[64 + ln];
      const float s1 = 0.5f * wave_sum(pa * __shfl_xor(pa, 32)), s2 = 0.5f * wave_sum(pb * __shfl_xor(pb, 32));
      lam_full = __int_as_float(__builtin_amdgcn_readfirstlane(__float_as_int(expf(s1) - expf(s2) + li))); }
    if (parts & 4) for (int it = bx; it < NB * 16; it += G) {
        __builtin_amdgcn_s_barrier();
        int ln = lane; asm volatile("" : "+v"(ln));
        const int g = (it >> 3) & 1;
        swa_wg_item(lds + RING_OFF, PROJ, (const bf16*)(ws + WS_SKV), MIX, it >> 4, g, (it & 7) * 8, PA[PA_SINK + layer * 16 + g * 8 + wave], ln, wave);
    }
    volatile LAS unsigned* bc = (volatile LAS unsigned*)(lds + MISC_OFF) + 16;
    unsigned* headw = (unsigned*)(ws + WS_CTL) + CW_QW + 64 * qslot;
    if (parts & 2) for (;;) {
        __builtin_amdgcn_s_barrier();
        if (wave == 0 && lane == 0) bc[0] = __hip_atomic_fetch_add(headw, 1u, __ATOMIC_RELAXED, __HIP_MEMORY_SCOPE_AGENT);
        asm volatile("s_waitcnt vmcnt(0) lgkmcnt(0)" ::: "memory");
        __builtin_amdgcn_s_barrier();
        const int it = __builtin_amdgcn_readfirstlane((int)bc[0]);
        if (it >= NB * 8 * 8) break;
        int ln = lane; asm volatile("" : "+v"(ln));
        const int pair = it & 127;
        diff_wg_item(lds + RING_OFF, PROJ, (const bf16*)(ws + WS_DKV), MIX, pair >> 3, pair & 7, 7 - (it >> 7), lam_full, 1.0f - li, PA + PA_SUB + layer * 64, ln, wave);
    }
}


#ifndef REP_MIX
#define REP_MIX 1
#endif
#ifndef PROBE_MIX_PART
#define PROBE_MIX_PART 0
#endif
#ifndef PROBE_PHASE
#define PROBE_PHASE -1
#define PROBE_REPS 0
#endif
#ifndef REP_NORM
#define REP_NORM 1
#endif
enum { L_PROJ = 0, L_GPREP, L_MIX, L_MIX2, L_OUT, L_XQ, L_XATT, L_XO, L_HALO, L_UP, L_DOWN, PH_PER_LAYER };
constexpr int PH_L0 = 2, PH_FINAL = PH_L0 + NLAYER * PH_PER_LAYER, NPHASE = PH_FINAL + 1;
struct Args { const float* in[22]; float* out; unsigned char* ws; int ph_lo, ph_hi; };
static_assert(sizeof(Args) == 200, "Args has no padding bytes");

__device__ __forceinline__ bool ph_in(int lo, int hi, int k) { asm volatile("" : "+s"(lo), "+s"(hi)); return lo <= k && k < hi; }
__device__ __forceinline__ bool ph_seam(int hi, int k) { asm volatile("" : "+s"(hi)); return k + 1 < hi; }
#define IN(k) ph_in(lo, hi, (k))
#define SEAM(k) do { if (ph_seam(hi, (k))) xcd_barrier(bar); } while (0)
#define PHASE_ENV() GAS unsigned char* wsg_ = (GAS unsigned char*)ws0; GAS float* outg_ = (GAS float*)out0; int tid_ = threadIdx.x, G = gridDim.x, bx = blockIdx.x; \
    asm volatile("" : "+s"(wsg_), "+s"(outg_), "+v"(tid_), "+s"(G), "+s"(bx)); \
    const int lane = tid_ & 63, wave = __builtin_amdgcn_readfirstlane(tid_ >> 6), gw = wave * G + bx, ngw = G * NWAVES;     \
    unsigned char* const ws = (unsigned char*)wsg_; float* const out = (float*)outg_; \
    bf16* const HB = (bf16*)(ws + WS_HB); bf16* const MIX = (bf16*)(ws + WS_XN); float* const SSQ = (float*)(ws + WS_SSQ); bf16* const PROJ = (bf16*)(ws + WS_PROJ); bf16* const ACT = PROJ; \
    bf16* const QXA = (bf16*)(ws + WS_QXA); bf16* const OXA = (bf16*)(ws + WS_OXA); bf16* const XH = (bf16*)(ws + WS_XH); float* const HALO = (float*)(ws + WS_HALO); \
    bf16* const KVMEM = (bf16*)(ws + WS_KVMEM); const float* const PA = (const float*)(ws + WS_PAR); \
    (void)HB; (void)SSQ; (void)MIX; (void)PROJ; (void)ACT; (void)QXA; (void)OXA; (void)XH; (void)HALO; (void)KVMEM; (void)PA; (void)out; (void)lane; (void)wave; (void)gw; (void)ngw; (void)G; (void)bx
#define LAYER_ENV() PHASE_ENV(); constexpr int l = L0

template <int L0>
__device__ __forceinline__ void layer_phases(LAS unsigned char* lds, const XcdBarrier bar, const int lo, const int hi, unsigned char* const ws0, float* const out0, const float* const xin) {
    constexpr int pb = PH_L0 + L0 * PH_PER_LAYER;
        if (IN(pb + L_PROJ)) { LAYER_ENV();
            pg8::Gemm g{HB, wlp(ws, l, WO_IN), T, NPROJ, D}; pg8::StaticOrder S; S.init(T, NPROJ, G, bx);
            pg8::EpiProj E{PROJ, NPROJ, SSQ, (bf16*)(ws + WS_DKV), (bf16*)(ws + WS_SKV), (bf16*)(ws + WS_GVF)};
            pg8::gemm_phase<pg8::EpiProj, pg8::StaticOrder, PG8_ALIGN, PG8_SP2>(lds + RING_OFF, g, S, E);
            SEAM(pb + L_PROJ);
        }
        if (IN(pb + L_GPREP)) { LAYER_ENV();
            for (int it = gw; it < NB * 4 * 32; it += ngw) { int ln = lane; asm volatile("" : "+v"(ln)); gla_prep_item(PROJ, ws, it >> 7, (it >> 5) & 3, it & 31, PA + PA_GB + l * 256, ln); }
            SEAM(pb + L_GPREP);
        }
        if (IN(pb + L_MIX)) { LAYER_ENV(); for (int rep = 0; rep < REP_MIX; ++rep) mix_wg_phase(lds, ws, l + 4 * rep, l, lane, wave, bx, G);
#if PROBE_MIX_PART != 0
            mix_wg_phase(lds, ws, l + 8, l, lane, wave, bx, G, PROBE_MIX_PART);
#endif
            SEAM(pb + L_MIX); }
        if (IN(pb + L_MIX2)) { LAYER_ENV();
            for (int rep = 0; rep < REP_MIX; ++rep) for (int r = gw; r < T; r += 2 * ngw) { const int r1 = r + ngw;
                if (r1 < T) gla_finish_row2(PROJ, (const float*)(ws + WS_OGLA), MIX, PA + PA_GNG + l * 128, r, r1, lane);
                else gla_finish_row(PROJ, (const float*)(ws + WS_OGLA), MIX, PA + PA_GNG + l * 128, r, lane); }
            SEAM(pb + L_MIX2);
        }
        if (IN(pb + L_OUT)) { LAYER_ENV();
            pg8::Gemm g{MIX, wlp(ws, l, WO_OUT), T, D, D}; pg8::StaticOrder S; S.init(T, D, G, bx);
            pg8::EpiResNorm E{HB, SSQ, nullptr, lds + XCH_OFF, D};
            pg8::gemm_phase<pg8::EpiResNorm, pg8::StaticOrder, true, PG8_SP2>(lds + RING_OFF, g, S, E);
            SEAM(pb + L_OUT);
        }
        if (IN(pb + L_XQ)) { LAYER_ENV();
            pg8::Gemm g{HB, wlp(ws, l, WO_XQ), T, DXA, D}; pg8::StaticOrder S; S.init(T, DXA, G, bx);
            pg8::EpiBf16S E{QXA, DXA, SSQ};
            pg8::gemm_phase<pg8::EpiBf16S, pg8::StaticOrder, PG8_ALIGN, PG8_SP2>(lds + RING_OFF, g, S, E);
            SEAM(pb + L_XQ);
        }
        if (IN(pb + L_XATT)) { LAYER_ENV();
            for (int rep = 0; rep < REP_MIX; ++rep) for (int it = bx; it < NB * 4 * 4; it += G) { int ln = lane; asm volatile("" : "+v"(ln));
                __builtin_amdgcn_s_barrier();
                xatt_wg_item(lds + RING_OFF, QXA, KVMEM, OXA, l, it >> 4, (it >> 2) & 3, it & 3, ln, wave); }
            SEAM(pb + L_XATT);
        }
        if (IN(pb + L_XO)) { LAYER_ENV();
            pg8::Gemm g{OXA, wlp(ws, l, WO_XO), T, D, DXA}; pg8::StaticOrder S; S.init(T, D, G, bx);
            pg8::EpiResNorm E{HB, SSQ, XH, lds + XCH_OFF, D};
            pg8::gemm_phase<pg8::EpiResNorm, pg8::StaticOrder, true, PG8_SP2>(lds + RING_OFF, g, S, E);
            SEAM(pb + L_XO);
        }
        if (IN(pb + L_HALO)) { LAYER_ENV();
            pg8::Gemm g{XH, wlp(ws, l, WO_UP), 256, NUP, D}; pg8::StaticOrder S; S.init(256, NUP, G, bx);
            pg8::EpiF32 E{HALO, NUP, SSQ};
            pg8::gemm_phase<pg8::EpiF32, pg8::StaticOrder, PG8_ALIGN, PG8_SP2>(lds + RING_OFF, g, S, E);
            if (bx >= 44) { float* RSTD = (float*)(ws + WS_RSTD);
                for (int r = (bx - 44) * (NWAVES * 64) + tid_; r < T; r += (G - 44) * (NWAVES * 64)) RSTD[r] = pg8::row_rstd(SSQ, r);
                if (l + 1 < NLAYER) {
                    const unsigned long long* pp = (const unsigned long long*)(ws + WS_PAR + PA_PTRS * 4);
                    const WSrc W{(const float*)(const GAS float*)pp[0], (const float*)(const GAS float*)pp[1], (const float*)(const GAS float*)pp[2], (const float*)(const GAS float*)pp[3],
                                 (const float*)(const GAS float*)pp[4], (const float*)(const GAS float*)pp[5], PA + PA_NMIX, PA + PA_NXA, PA + PA_NFFN};
                    LAS float* scr = (LAS float*)(lds + RING_OFF + wave * 16384);
                    for (int it = (bx - 44) + wave * (G - 44); it < TI_LAYER_NOKV; it += (G - 44) * NWAVES) convert_layer_item(W, ws, l + 1, it, scr, lane);
                } }
            SEAM(pb + L_HALO);
        }
        if (IN(pb + L_UP)) { LAYER_ENV();
            pg8::Gemm g{HB, wlp(ws, l, WO_UP), T, NUP, D}; pg8::StaticOrder S; S.init(T, NUP, G, bx);
            pg8::EpiConvGlu E{ACT, PA + PA_CW + l * 3 * NUP, PA + PA_CB + l * NUP, HALO, (const float*)(ws + WS_RSTD), lds + XCH_OFF, DFF, NUP};
            pg8::gemm_phase<pg8::EpiConvGlu, pg8::StaticOrder, true, PG8_SP2>(lds + RING_OFF, g, S, E);
            SEAM(pb + L_UP);
        }
        if (IN(pb + L_DOWN)) { LAYER_ENV();
            pg8::Gemm g{ACT, wlp(ws, l, WO_DN), T, D, DFF}; pg8::StaticOrder S; S.init(T, D, G, bx);
            pg8::EpiResNorm E{HB, SSQ, nullptr, lds + XCH_OFF, D};
            pg8::gemm_phase<pg8::EpiResNorm, pg8::StaticOrder, true, PG8_SP2>(lds + RING_OFF, g, S, E);
            SEAM(pb + L_DOWN);
        }
}

__global__ void __launch_bounds__(NWAVES * 64, 2) trunk_fwd(Args args) {
    extern __shared__ __attribute__((aligned(16))) unsigned char lds_raw[];
    LAS unsigned char* lds = (LAS unsigned char*)lds_raw;
    volatile LAS unsigned* MISC = (volatile LAS unsigned*)(lds + MISC_OFF);
    const int tid = threadIdx.x;
    unsigned char* const ws0 = args.ws; float* const out0 = args.out;
    const int lo = args.ph_lo, hi = args.ph_hi;
    for (int u = tid; u < (LDS_BYTES - MISC_OFF) / 4; u += NWAVES * 64) ((LAS unsigned*)(lds + MISC_OFF))[u] = 0u;
    __syncthreads();
    XcdBarrier bar; bar.bar = (unsigned*)(ws0 + WS_CTL) + CW_BAR; bar.x = 0; bar.st = nullptr;
    if (hi - lo > 1) bar = xcd_barrier_post((unsigned*)(ws0 + WS_CTL) + CW_BAR, MISC + 8);
    if (IN(0)) { PHASE_ENV(); Ptrs PP;
#pragma unroll
        for (int i = 0; i < 22; ++i) PP.in[i] = args.in[i];
        PP.out = out; PP.ws = ws;
        prologue_phase(PP, lds, gw, ngw, wave, lane); SEAM(0); }
    if (IN(1)) { PHASE_ENV();
        pg8::Gemm g{(const bf16*)(ws + WS_MEMN), (const bf16*)(ws + WS_WKV), MROWS, 4096, D}; pg8::StaticOrder S; S.init(MROWS, 4096, G, bx);
        pg8::EpiKvFrag E{KVMEM};
        pg8::gemm_phase<pg8::EpiKvFrag, pg8::StaticOrder, PG8_ALIGN, PG8_SP2>(lds + RING_OFF, g, S, E);
    }
    layer_phases<0>(lds, bar, lo, hi, ws0, out0, args.in[0]);
    layer_phases<1>(lds, bar, lo, hi, ws0, out0, args.in[0]);
    layer_phases<2>(lds, bar, lo, hi, ws0, out0, args.in[0]);
    layer_phases<3>(lds, bar, lo, hi, ws0, out0, args.in[0]);
    if (IN(PH_FINAL)) { PHASE_ENV();
        for (int r = gw; r < T; r += 2 * ngw) { const int r1 = r + ngw;
            if (r1 < T) rms_row_final2(HB + (size_t)r * D, HB + (size_t)r1 * D, out + (size_t)r * D, out + (size_t)r1 * D, PA + PA_FIN, SSQ + (size_t)r * 8, SSQ + (size_t)r1 * 8, lane);
            else rms_row_final(HB + (size_t)r * D, out + (size_t)r * D, PA + PA_FIN, SSQ + (size_t)r * 8, lane); }
    }
#undef IN
#undef SEAM
}

extern "C" void kernel_launch(void* const* d_in, const int* in_sizes, int n_in, void* d_out, int out_size, void* d_ws, size_t ws_size, hipStream_t stream) {
    static int grid = 0;
    if (grid == 0) {
        if (n_in != 22 || in_sizes[0] != T * D || out_size != T * D || ws_size < WS_END) { fprintf(stderr, "kernel_launch: unexpected problem (n_in %d, in0 %d, out %d, ws %zu < %zu); nothing launched\n", n_in, n_in > 0 ? in_sizes[0] : -1, out_size, ws_size, (size_t)WS_END); grid = -1; return; }
        int dev = 0, cus = 0, per_cu = 0;
        if (hipGetDevice(&dev) != hipSuccess || hipDeviceGetAttribute(&cus, hipDeviceAttributeMultiprocessorCount, dev) != hipSuccess) { grid = -1; return; }
        if (hipFuncSetAttribute((const void*)trunk_fwd, hipFuncAttributeMaxDynamicSharedMemorySize, LDS_BYTES) != hipSuccess) { fprintf(stderr, "kernel_launch: hipFuncSetAttribute failed\n"); grid = -1; return; }
        if (hipOccupancyMaxActiveBlocksPerMultiprocessor(&per_cu, (const void*)trunk_fwd, NWAVES * 64, LDS_BYTES) != hipSuccess || per_cu < 1) fprintf(stderr, "kernel_launch: occupancy query reports %d workgroups per CU\n", per_cu);
        (void)hipGetLastError();
        grid = cus;
    }
    if (grid < 0) return;
    (void)hipMemsetAsync((char*)d_ws + WS_CTL, 0, CTL_ZERO_BYTES, stream);
    Args a{};
    for (int i = 0; i < 22; ++i) a.in[i] = (const float*)d_in[i];
    a.out = (float*)d_out; a.ws = (unsigned char*)d_ws;
#if MK_ONE_LAUNCH
    a.ph_lo = 0; a.ph_hi = NPHASE;
    hipLaunchKernelGGL(trunk_fwd, dim3(grid), dim3(NWAVES * 64), LDS_BYTES, stream, a);
#else
    for (int p = 0; p < NPHASE; ++p) { a.ph_lo = p; a.ph_hi = p + 1;
        const int reps = 1 + (p == PROBE_PHASE ? PROBE_REPS : 0);
        for (int rep = 0; rep < reps; ++rep) hipLaunchKernelGGL(trunk_fwd, dim3(grid), dim3(NWAVES * 64), LDS_BYTES, stream, a); }
#endif
}
```

```cpp
#include <hip/hip_runtime.h>
#include <cstdio>
#include <cstdint>
namespace pg8 {
#define PG8_LAS __attribute__((address_space(3)))
typedef unsigned short bf16_t;
typedef short bf16x8 __attribute__((ext_vector_type(8)));
typedef float f32x4 __attribute__((ext_vector_type(4)));
typedef unsigned u32x4 __attribute__((ext_vector_type(4)));
constexpr int BM = 256, BK = 64, HALF = 128, HTB = HALF * BK * 2  , STAGE_BYTES = 8 * HTB, NXCD = 8, WGM = 4;

__host__ __device__ __forceinline__ int lds_byte(int r, int c) { const int st = (r >> 4) * 2 + (c >> 5), rr = r & 15, cc = c & 31, ob = rr * 64 + cc * 2; return st * 1024 + (ob ^ (((ob >> 9) & 1) << 5)); }
__host__ __device__ __forceinline__ void stage_rc(int b, int& R, int& C) { const int st = b / 1024, sb = b % 1024, swz = sb ^ (((sb >> 9) & 1) << 5); R = (st >> 1) * 16 + swz / 64; C = (st & 1) * 32 + (swz % 64) / 2; }
__host__ __device__ __forceinline__ int perm32(int rho) { const int n = rho >> 4, i = rho & 15; return 8 * (i >> 2) + 4 * n + (i & 3); }

struct Unit { int pm, pn; };
struct Gemm { const bf16_t* A; const bf16_t* Bt; int M, N, K; };

struct StaticOrder {
    int nM, nN, nwg, G, c;
    __host__ __device__ void init(int M, int N, int G_, int c_) { nM = M / BM; nN = N / BM; nwg = nM * nN; G = G_; c = c_; }
    __host__ __device__ bool next(int i, Unit& u) const {
        const long L = (long)i * G + c; if (L >= nwg) return false;
        int wgid = (int)L; { const int q = nwg / NXCD, r = nwg % NXCD, xcd = wgid % NXCD, off = wgid / NXCD; wgid = (xcd < r ? xcd * (q + 1) : r * (q + 1) + (xcd - r) * q) + off; }
        const int nig = WGM * nN, gid = wgid / nig, fm = gid * WGM, gsz = (nM - fm) < WGM ? (nM - fm) : WGM;
        u.pm = fm + ((wgid % nig) % gsz); u.pn = (wgid % nig) / gsz; return true;
    }
    __device__ __forceinline__ void a_ready(const Unit&) const {}
    __device__ __forceinline__ void done(const Unit&) const {}
};

typedef float f32x2c_t __attribute__((ext_vector_type(2))); typedef __bf16 bf16x2c_t __attribute__((ext_vector_type(2)));
__device__ __forceinline__ unsigned cvt_pk_bf16(float lo, float hi) { f32x2c_t v = {lo, hi}; bf16x2c_t b = __builtin_convertvector(v, bf16x2c_t); return __builtin_bit_cast(unsigned, b); }
template <class Epi, class Sched, bool ALIGN_EPI = false, bool SP2 = false>
__device__ __forceinline__ void gemm_phase(PG8_LAS unsigned char* lds, const Gemm g, const Sched& S, const Epi& E) {
    int tid_ = threadIdx.x; asm volatile("" : "+v"(tid_));
    const int tid = tid_, wid = __builtin_amdgcn_readfirstlane(tid >> 6), lane = tid & 63, wr = wid >> 2, wc = wid & 3, fr = lane & 15, fq = lane >> 4;
    const int K = g.K, nt = K / BK;
    unsigned voffA[2], voffB[2];
#pragma unroll
    for (int i = 0; i < 2; ++i) { int R, C; stage_rc(tid * 16 + i * 8192, R, C); const int Rb = Epi::PERM ? ((R & ~31) + perm32(R & 31)) : R;
        voffA[i] = (unsigned)(R * K + C) * 2u; voffB[i] = (unsigned)(Rb * K + C) * 2u; }
    const size_t kstep = (size_t)(BK * 2);
    const size_t hstep = (size_t)HALF * K * 2;
    const size_t tstep = 2 * hstep;
    const unsigned ldsw = (unsigned)wid * 1024u;
    const int aoff = lds_byte(wr * 64 + fr, fq * 8), boff = lds_byte(wc * 32 + fr, fq * 8);
#define PG8_SA(b, h) (((b) * 2 + (h)) * HTB)
#define PG8_SB(b, h) ((4 + (b) * 2 + (h)) * HTB)
#define PG8_STAGE(bufoff, gbase, voff) do { _Pragma("unroll") for (int _i = 0; _i < 2; ++_i) \
        __builtin_amdgcn_global_load_lds((const unsigned*)((const char*)(gbase) + (voff)[_i]), (PG8_LAS unsigned*)(lds + (bufoff) + ldsw + _i * 8192), 16, 0, 0); } while (0)
#define PG8_LDA(dst, b, h) do { _Pragma("unroll") for (int m = 0; m < 4; ++m) _Pragma("unroll") for (int k = 0; k < 2; ++k) dst[m][k] = *(const PG8_LAS bf16x8*)(lds + PG8_SA(b, h) + aoff + m * 2048 + k * 1024); } while (0)
#define PG8_LDB(dst, b, h) do { _Pragma("unroll") for (int n = 0; n < 2; ++n) _Pragma("unroll") for (int k = 0; k < 2; ++k) dst[n][k] = *(const PG8_LAS bf16x8*)(lds + PG8_SB(b, h) + boff + n * 2048 + k * 1024); } while (0)
#define PG8_MMA(ai, bj, At, Bt) do { __builtin_amdgcn_s_setprio(1); _Pragma("unroll") for (int m = 0; m < 4; ++m) _Pragma("unroll") for (int n = 0; n < 2; ++n) _Pragma("unroll") for (int k = 0; k < 2; ++k) \
        acc[ai][bj][m][n] = __builtin_amdgcn_mfma_f32_16x16x32_bf16(Bt[n][k], At[m][k], acc[ai][bj][m][n], 0, 0, 0); __builtin_amdgcn_s_setprio(0); } while (0)
#define PG8_WAIT_V(n) asm volatile("s_waitcnt vmcnt(" #n ")" ::: "memory")
#define PG8_WAIT_L(n) asm volatile("s_waitcnt lgkmcnt(" #n ")" ::: "memory")
#define PG8_BAR __builtin_amdgcn_s_barrier()
#define PG8_SCHED __builtin_amdgcn_sched_barrier(0)
    Unit cur, nxt; int ui = 0;
    if (!S.next(0, cur)) return;
    f32x4 acc[2][2][4][2];
#pragma unroll
    for (int a = 0; a < 2; ++a)
#pragma unroll
        for (int b = 0; b < 2; ++b)
#pragma unroll
            for (int m = 0; m < 4; ++m)
#pragma unroll
                for (int n = 0; n < 2; ++n) acc[a][b][m][n] = (f32x4){0.f, 0.f, 0.f, 0.f};
    bf16x8 At[4][2], B0[2][2], B1[2][2];
    const char* cA = (const char*)g.A + (size_t)cur.pm * tstep; const char* cB = (const char*)g.Bt + (size_t)cur.pn * tstep;
    S.a_ready(cur);
    if constexpr (SP2) {
        PG8_STAGE(PG8_SB(0, 0), cB, voffB); PG8_STAGE(PG8_SB(0, 1), cB + hstep, voffB); PG8_STAGE(PG8_SA(0, 0), cA, voffA); PG8_STAGE(PG8_SA(0, 1), cA + hstep, voffA);
        if (wr == 1) PG8_BAR;
        PG8_WAIT_V(2); PG8_BAR;
        PG8_STAGE(PG8_SB(1, 0), cB + kstep, voffB); PG8_STAGE(PG8_SA(1, 0), cA + kstep, voffA); PG8_STAGE(PG8_SB(1, 1), cB + hstep + kstep, voffB);
        PG8_WAIT_V(6); PG8_BAR;
    } else {
        PG8_STAGE(PG8_SB(0, 0), cB, voffB); PG8_STAGE(PG8_SA(0, 0), cA, voffA); PG8_STAGE(PG8_SB(0, 1), cB + hstep, voffB); PG8_STAGE(PG8_SA(0, 1), cA + hstep, voffA);
        if (wr == 1) PG8_BAR;
        PG8_WAIT_V(4); PG8_BAR;
        PG8_STAGE(PG8_SB(1, 0), cB + kstep, voffB); PG8_STAGE(PG8_SA(1, 0), cA + kstep, voffA); PG8_STAGE(PG8_SB(1, 1), cB + hstep + kstep, voffB);
        PG8_WAIT_V(6); PG8_BAR;
    }
    for (;;) {
        const bool has_next = S.next(ui + 1, nxt);
        const char* nA = has_next ? (const char*)g.A + (size_t)nxt.pm * tstep : cA; const char* nB = has_next ? (const char*)g.Bt + (size_t)nxt.pn * tstep : cB;
        for (int t = 0; t < nt; t += 2) {
            const bool last = (t == nt - 2);
            const char* a1 = cA + (size_t)(t + 1) * kstep;
            const char* a2 = last ? nA : cA + (size_t)(t + 2) * kstep; const char* b2 = last ? nB : cB + (size_t)(t + 2) * kstep;
            const char* a3 = a2 + kstep; const char* b3 = b2 + kstep;
            if (last && has_next) S.a_ready(nxt);
            if constexpr (SP2) {
            PG8_LDB(B0, 0, 0); PG8_LDB(B1, 0, 1); PG8_SCHED; PG8_LDA(At, 0, 0); PG8_STAGE(PG8_SA(1, 1), a1 + hstep, voffA);
            PG8_WAIT_V(8); PG8_WAIT_L(0); PG8_BAR; PG8_MMA(0, 0, At, B0); PG8_MMA(0, 1, At, B1); PG8_BAR; PG8_SCHED;
            PG8_LDA(At, 0, 1); PG8_STAGE(PG8_SB(0, 0), b2, voffB); PG8_STAGE(PG8_SB(0, 1), b2 + hstep, voffB); PG8_STAGE(PG8_SA(0, 0), a2, voffA);
            PG8_WAIT_V(8); PG8_WAIT_L(0); PG8_BAR; PG8_MMA(1, 0, At, B0); PG8_MMA(1, 1, At, B1); PG8_BAR; PG8_SCHED;
            PG8_LDB(B0, 1, 0); PG8_LDB(B1, 1, 1); PG8_SCHED; PG8_LDA(At, 1, 0); PG8_STAGE(PG8_SA(0, 1), a2 + hstep, voffA);
            PG8_WAIT_V(8); PG8_WAIT_L(0); PG8_BAR; PG8_MMA(0, 0, At, B0); PG8_MMA(0, 1, At, B1); PG8_BAR; PG8_SCHED;
            PG8_LDA(At, 1, 1); PG8_STAGE(PG8_SB(1, 0), b3, voffB); PG8_STAGE(PG8_SB(1, 1), b3 + hstep, voffB); PG8_STAGE(PG8_SA(1, 0), a3, voffA);
            PG8_WAIT_V(8); PG8_WAIT_L(0); PG8_BAR; PG8_MMA(1, 0, At, B0); PG8_MMA(1, 1, At, B1); PG8_BAR; PG8_SCHED;
            } else {
            PG8_LDB(B0, 0, 0); PG8_SCHED; PG8_LDA(At, 0, 0); PG8_STAGE(PG8_SA(1, 1), a1 + hstep, voffA);
            PG8_WAIT_L(8); PG8_BAR; PG8_WAIT_L(0); PG8_MMA(0, 0, At, B0); PG8_BAR; PG8_SCHED;
            PG8_LDB(B1, 0, 1); PG8_STAGE(PG8_SB(0, 0), b2, voffB);
            PG8_BAR; PG8_WAIT_L(0); PG8_MMA(0, 1, At, B1); PG8_BAR;
            PG8_LDA(At, 0, 1); PG8_STAGE(PG8_SA(0, 0), a2, voffA);
            PG8_BAR; PG8_WAIT_L(0); PG8_MMA(1, 0, At, B0); PG8_BAR; PG8_SCHED;
            PG8_STAGE(PG8_SB(0, 1), b2 + hstep, voffB);
            PG8_WAIT_V(6); PG8_BAR; PG8_MMA(1, 1, At, B1); PG8_BAR;
            PG8_LDB(B0, 1, 0); PG8_SCHED; PG8_LDA(At, 1, 0); PG8_STAGE(PG8_SA(0, 1), a2 + hstep, voffA);
            PG8_WAIT_L(8); PG8_BAR; PG8_WAIT_L(0); PG8_MMA(0, 0, At, B0); PG8_BAR; PG8_SCHED;
            PG8_LDB(B1, 1, 1); PG8_STAGE(PG8_SB(1, 0), b3, voffB);
            PG8_BAR; PG8_WAIT_L(0); PG8_MMA(0, 1, At, B1); PG8_BAR;
            PG8_LDA(At, 1, 1); PG8_STAGE(PG8_SA(1, 0), a3, voffA);
            PG8_BAR; PG8_WAIT_L(0); PG8_MMA(1, 0, At, B0); PG8_BAR; PG8_SCHED;
            PG8_STAGE(PG8_SB(1, 1), b3 + hstep, voffB);
            PG8_WAIT_V(6); PG8_BAR; PG8_MMA(1, 1, At, B1); PG8_BAR;
            }
        }
        if constexpr (ALIGN_EPI) { if (wr == 0) PG8_BAR; }
        if constexpr (!Epi::AFTER_DRAIN) { E(acc, cur, wr, wc, fr, fq); S.done(cur); }
        if (!has_next) break;
#pragma unroll
        for (int a = 0; a < 2; ++a)
#pragma unroll
            for (int b = 0; b < 2; ++b)
#pragma unroll
                for (int m = 0; m < 4; ++m)
#pragma unroll
                    for (int n = 0; n < 2; ++n) acc[a][b][m][n] = (f32x4){0.f, 0.f, 0.f, 0.f};
        cur = nxt; cA = nA; cB = nB; ++ui;
        if constexpr (ALIGN_EPI) { if (wr == 1) PG8_BAR; }
    }
    PG8_WAIT_V(0);
    if constexpr (!ALIGN_EPI) { if (wr == 0) PG8_BAR; }
    PG8_BAR;
    if constexpr (Epi::AFTER_DRAIN) { E.fused(acc, cur, wr, wc, fr, fq, lds, wid, lane); S.done(cur); }
#undef PG8_SA
#undef PG8_SB
#undef PG8_STAGE
#undef PG8_LDA
#undef PG8_LDB
#undef PG8_MMA
#undef PG8_WAIT_V
#undef PG8_WAIT_L
#undef PG8_BAR
#undef PG8_SCHED
}

__device__ __forceinline__ float row_rstd(const float* ssq, int row) {
    const f32x4 a = *(const f32x4*)(ssq + (size_t)row * 8), b = *(const f32x4*)(ssq + (size_t)row * 8 + 4);
    return __builtin_amdgcn_rsqf(((a[0] + a[1]) + (a[2] + a[3]) + (b[0] + b[1]) + (b[2] + b[3])) * (1.0f / 2048.0f) + 1e-6f);
}
struct EpiBf16S {
    static constexpr bool PERM = true, AFTER_DRAIN = false;
    bf16_t* O; int ldc; const float* ssq;
    __device__ __forceinline__ void operator()(f32x4 (&acc)[2][2][4][2], const Unit& u, int wr, int wc, int fr, int fq) const {
        { int l_ = threadIdx.x & 63; asm volatile("" : "+v"(l_)); fr = l_ & 15; fq = l_ >> 4; }
        const int row0 = u.pm * BM + wr * 64 + fr; const int col0 = u.pn * BM + wc * 32 + 8 * fq;
#pragma unroll
        for (int ai = 0; ai < 2; ++ai)
#pragma unroll
            for (int m = 0; m < 4; ++m) { const int row = row0 + ai * HALF + m * 16; bf16_t* rowp = O + (size_t)row * ldc + col0;
                const float rs = ssq ? row_rstd(ssq, row) : 1.0f;
#pragma unroll
                for (int bj = 0; bj < 2; ++bj) { const f32x4 v0 = acc[ai][bj][m][0] * rs, v1 = acc[ai][bj][m][1] * rs;
                    u32x4 w; w.x = cvt_pk_bf16(v0[0], v0[1]); w.y = cvt_pk_bf16(v0[2], v0[3]); w.z = cvt_pk_bf16(v1[0], v1[1]); w.w = cvt_pk_bf16(v1[2], v1[3]);
                    *(u32x4*)(rowp + bj * HALF) = w; } }
    }
};
struct EpiResNorm {
    static constexpr bool PERM = true, AFTER_DRAIN = false;
    bf16_t* hb; float* ssq; bf16_t* xh; PG8_LAS unsigned char* xch; int ldc;
    __device__ __forceinline__ void operator()(f32x4 (&acc)[2][2][4][2], const Unit& u, int wr, int wc, int fr, int fq) const {
        { int l_ = threadIdx.x & 63; asm volatile("" : "+v"(l_)); fr = l_ & 15; fq = l_ >> 4; }
        const int col0 = u.pn * BM + wc * 32 + 8 * fq;
        PG8_LAS float* P = (PG8_LAS float*)xch;
        const unsigned off0 = (unsigned)((u.pm * BM + wr * 64 + fr) * ldc + col0);
        u32x4 nb[2];
#pragma unroll
        for (int bj = 0; bj < 2; ++bj) nb[bj] = *(const u32x4*)(hb + off0 + bj * HALF);
#pragma unroll
        for (int ai = 0; ai < 2; ++ai)
#pragma unroll
            for (int m = 0; m < 4; ++m) { const int rl = ai * HALF + wr * 64 + m * 16 + fr; const unsigned off = off0 + (unsigned)((ai * HALF + m * 16) * ldc);
                const u32x4 c0 = nb[0], c1 = nb[1];
                if (ai * 4 + m < 7) { const unsigned offn = off0 + (unsigned)((((ai * 4 + m + 1) >> 2) * HALF + ((ai * 4 + m + 1) & 3) * 16) * ldc);
#pragma unroll
                    for (int bj = 0; bj < 2; ++bj) nb[bj] = *(const u32x4*)(hb + offn + bj * HALF); }
                asm volatile("" ::: "memory");
                float ss = 0.f;
#pragma unroll
                for (int bj = 0; bj < 2; ++bj) { const u32x4 cw = bj == 0 ? c0 : c1;
                    f32x4 b0, b1;
                    b0[0] = __uint_as_float(cw[0] << 16); b0[1] = __uint_as_float(cw[0] & 0xffff0000u); b0[2] = __uint_as_float(cw[1] << 16); b0[3] = __uint_as_float(cw[1] & 0xffff0000u);
                    b1[0] = __uint_as_float(cw[2] << 16); b1[1] = __uint_as_float(cw[2] & 0xffff0000u); b1[2] = __uint_as_float(cw[3] << 16); b1[3] = __uint_as_float(cw[3] & 0xffff0000u);
                    const f32x4 v0 = b0 + acc[ai][bj][m][0], v1 = b1 + acc[ai][bj][m][1];
                    ss += (v0[0] * v0[0] + v0[1] * v0[1]) + (v0[2] * v0[2] + v0[3] * v0[3]) + (v1[0] * v1[0] + v1[1] * v1[1]) + (v1[2] * v1[2] + v1[3] * v1[3]);
                    u32x4 w; w.x = cvt_pk_bf16(v0[0], v0[1]); w.y = cvt_pk_bf16(v0[2], v0[3]); w.z = cvt_pk_bf16(v1[0], v1[1]); w.w = cvt_pk_bf16(v1[2], v1[3]);
                    *(u32x4*)(hb + off + bj * HALF) = w;
                    if (xh != nullptr && ai == 1 && m == 3 && wr == 1 && fr >= 14) { const int p = u.pm + 1;
                        if (p < 128 && (p & 7) != 0) *(u32x4*)(xh + (unsigned)((2 * p + fr - 14) * ldc + col0 + bj * HALF)) = w; }
                }
                ss += __shfl_xor(ss, 16); ss += __shfl_xor(ss, 32);
                if (fq == 0) P[rl * 4 + wc] = ss;
            }
        asm volatile("s_waitcnt lgkmcnt(0)" ::: "memory"); __builtin_amdgcn_s_barrier(); asm volatile("" ::: "memory");
        const int t = (wr * 4 + wc) * 64 + fq * 16 + fr;
        if (t < BM) { const f32x4 q = *(const PG8_LAS f32x4*)(P + t * 4); ssq[(size_t)(u.pm * BM + t) * 8 + u.pn] = (q[0] + q[1]) + (q[2] + q[3]); }
    }
};
struct EpiF32 {
    static constexpr bool PERM = false, AFTER_DRAIN = false;
    float* out; int ldc; const float* ssq;
    __device__ __forceinline__ void operator()(f32x4 (&acc)[2][2][4][2], const Unit& u, int wr, int wc, int fr, int fq) const {
        { int l_ = threadIdx.x & 63; asm volatile("" : "+v"(l_)); fr = l_ & 15; fq = l_ >> 4; }
        const int col0 = u.pn * BM + wc * 32 + 4 * fq;
#pragma unroll
        for (int ai = 0; ai < 2; ++ai)
#pragma unroll
            for (int m = 0; m < 4; ++m) { const int r = u.pm * BM + ai * HALF + wr * 64 + m * 16 + fr; const size_t off = (size_t)r * ldc + col0;
                int src = 256 * (r >> 1) - 2 + (r & 1); src = src < 0 ? 0 : src;
                const float rs = row_rstd(ssq, src);
#pragma unroll
                for (int bj = 0; bj < 2; ++bj)
#pragma unroll
                    for (int n = 0; n < 2; ++n) *(f32x4*)(out + off + bj * HALF + n * 16) = acc[ai][bj][m][n] * rs; }
    }
};
typedef unsigned u32x2 __attribute__((ext_vector_type(2)));
struct EpiConvGlu {
    static constexpr bool PERM = true, AFTER_DRAIN = false;
    bf16_t* act; const float* cw; const float* cb; const float* halo; const float* rstd; PG8_LAS unsigned char* xch; int dff; int nup;
    __device__ __forceinline__ void operator()(f32x4 (&acc)[2][2][4][2], const Unit& u, int wr, int wc, int fr, int fq) const {
        { int l_ = threadIdx.x & 63; asm volatile("" : "+v"(l_), "+s"(wr), "+s"(wc)); fr = l_ & 15; fq = l_ >> 4; }
        const int lane = fq * 16 + fr;
        PG8_LAS f32x4* X = (PG8_LAS f32x4*)xch;
#pragma unroll
        for (int ai = 0; ai < 2; ++ai) {
            float rs[4];
#pragma unroll
            for (int m = 0; m < 4; ++m) rs[m] = rstd[u.pm * BM + ai * HALF + wr * 64 + m * 16 + fr];
#pragma unroll
            for (int m = 0; m < 4; ++m)
#pragma unroll
                for (int bj = 0; bj < 2; ++bj)
#pragma unroll
                    for (int n = 0; n < 2; ++n) acc[ai][bj][m][n] = acc[ai][bj][m][n] * rs[m];
            asm volatile("" ::: "memory"); }
        if (fr >= 14) {
#pragma unroll
            for (int ai = 0; ai < 2; ++ai)
#pragma unroll
                for (int bj = 0; bj < 2; ++bj)
#pragma unroll
                    for (int n = 0; n < 2; ++n) X[((((ai * 2 + wr) * 4 + wc) * 2 + bj) * 2 + n) * 8 + fq * 2 + (fr - 14)] = acc[ai][bj][3][n];
        }
        asm volatile("s_waitcnt lgkmcnt(0)" ::: "memory"); __builtin_amdgcn_s_barrier(); asm volatile("" ::: "memory");
        const int chb = u.pn * HALF + wc * 32 + 8 * fq;
        const int src1 = ((lane & 48) | ((fr + 15) & 15)) << 2, src2 = ((lane & 48) | ((fr + 14) & 15)) << 2;
        f32x4 hal[2][2];
#pragma unroll
        for (int n = 0; n < 2; ++n)
#pragma unroll
            for (int bj = 0; bj < 2; ++bj) { f32x4 v = (f32x4){0.f, 0.f, 0.f, 0.f};
                if (fr >= 14 && wr == 0 && (u.pm & 7) != 0) v = *(const f32x4*)(halo + (unsigned)((2 * u.pm + fr - 14) * nup + u.pn * BM + bj * HALF + wc * 32 + 8 * fq + 4 * n));
                hal[n][bj] = v; }
        u32x2 keep[2][4];
#pragma unroll
        for (int n = 0; n < 2; ++n) {
            f32x4 cwv[2][3], cbv[2];
#pragma unroll
            for (int bj = 0; bj < 2; ++bj) { const int ch = bj * dff + chb + 4 * n;
                cwv[bj][0] = *(const f32x4*)(cw + ch); cwv[bj][1] = *(const f32x4*)(cw + nup + ch); cwv[bj][2] = *(const f32x4*)(cw + 2 * nup + ch); cbv[bj] = *(const f32x4*)(cb + ch); }
#pragma unroll
            for (int ai = 0; ai < 2; ++ai) {
                f32x4 bnd[2];
#pragma unroll
                for (int bj = 0; bj < 2; ++bj) {
                    f32x4 v = (f32x4){0.f, 0.f, 0.f, 0.f};
                    if (fr >= 14) {
                        if (ai == 0 && wr == 0) v = hal[n][bj];
                        else { const int pai = (wr == 1) ? ai : 0, pwr = (wr == 1) ? 0 : 1;
                               v = X[((((pai * 2 + pwr) * 4 + wc) * 2 + bj) * 2 + n) * 8 + fq * 2 + (fr - 14)]; }
                    }
                    bnd[bj] = v;
                }
#pragma unroll
                for (int m = 0; m < 4; ++m) {
                    float a[4];
#pragma unroll
                    for (int j = 0; j < 4; ++j) {
                        float hc[2];
#pragma unroll
                        for (int bj = 0; bj < 2; ++bj) {
                            const float cur = acc[ai][bj][m][n][j];
                            const float prv = (m == 0) ? bnd[bj][j] : acc[ai][bj][m == 0 ? 0 : m - 1][n][j];
                            const float p1 = __int_as_float(__builtin_amdgcn_update_dpp(__builtin_amdgcn_mov_dpp(__float_as_int(prv), 0x121, 0xf, 0xf, false), __float_as_int(cur), 0x111, 0xf, 0xf, false));
                            const float p2 = __int_as_float(__builtin_amdgcn_update_dpp(__builtin_amdgcn_mov_dpp(__float_as_int(prv), 0x122, 0xf, 0xf, false), __float_as_int(cur), 0x112, 0xf, 0xf, false));
                            hc[bj] = cwv[bj][0][j] * p2 + cwv[bj][1][j] * p1 + cwv[bj][2][j] * cur + cbv[bj][j];
                        }
                        a[j] = hc[0] * hc[1] * __builtin_amdgcn_rcpf(1.0f + __builtin_amdgcn_exp2f(hc[0] * -1.4426950408889634f));
                    }
                    u32x2 w; w.x = cvt_pk_bf16(a[0], a[1]); w.y = cvt_pk_bf16(a[2], a[3]);
                    if (n == 0) { keep[ai][m] = w; asm volatile("" : "+v"(keep[ai][m].x), "+v"(keep[ai][m].y) :: "memory"); }
                    else { u32x4 w4; w4.x = keep[ai][m].x; w4.y = keep[ai][m].y; w4.z = w.x; w4.w = w.y;
                        *(u32x4*)(act + (unsigned)((u.pm * BM + ai * HALF + wr * 64 + m * 16 + fr) * dff + chb)) = w4; }
                }
            }
        }
    }
};
}

#ifndef PG8_SP2
#define PG8_SP2 true
#endif
#ifndef PG8_ALIGN
#define PG8_ALIGN true
#endif
#ifndef MK_ONE_LAUNCH
#define MK_ONE_LAUNCH 1
#endif

constexpr int NWAVES = 8;
constexpr int NB = 16, SEQ = 2048, D = 2048, T = NB * SEQ, NLAYER = 4;
constexpr int NMEM = 256, MROWS = NB * NMEM;
constexpr int NPROJ = 4608;
constexpr int DFF = 5632, NUP = 2 * DFF;
constexpr int DXA = 512;
constexpr float EPS = 1e-6f;
constexpr int C_DQ = 0, C_DK = 512, C_DV = 1024, C_SQ = 1536, C_SK = 2560, C_SV = 2688, C_GQ = 2816, C_GK = 3072, C_GV = 3328, C_OG = 3840, C_Z = 4352;
constexpr int WIN_LD = 4368;
constexpr int M_DIFF = 0, M_SWA = 512, M_GLA = 1536;

constexpr size_t MiB = 1u << 20;
constexpr size_t WS_CTL = 0, CTL_ZERO_BYTES = 1 * MiB;
constexpr size_t WS_PAR = 1 * MiB;
constexpr size_t WS_W = 2 * MiB, WL_STRIDE = 96 * MiB;
constexpr size_t WO_IN = 0, WO_OUT = 18 * MiB, WO_XQ = 26 * MiB, WO_XO = 28 * MiB, WO_UP = 30 * MiB, WO_DN = 74 * MiB;
constexpr size_t WS_WKV = WS_W + NLAYER * WL_STRIDE;
constexpr size_t WS_MEMN = WS_WKV + 16 * MiB;
constexpr size_t WS_KVMEM = WS_MEMN + 16 * MiB;
constexpr size_t WS_XN = WS_KVMEM + 32 * MiB;
constexpr size_t WS_QXA = WS_XN + 128 * MiB;
constexpr size_t WS_OXA = WS_QXA + 32 * MiB;
constexpr size_t WS_XH = WS_OXA + 32 * MiB;
constexpr size_t WS_HALO = WS_XH + 1 * MiB;
constexpr size_t WS_OGLA = WS_HALO + 11 * MiB;
constexpr size_t WS_PROJ = WS_OGLA + 64 * MiB;
constexpr size_t WS_GQD = WS_PROJ + 352 * MiB;
constexpr size_t WS_GKI = WS_GQD + 16 * MiB;
constexpr size_t WS_GEB = WS_GKI + 16 * MiB;
constexpr size_t WS_HB = WS_GEB + 1 * MiB;
constexpr size_t WS_SSQ = WS_HB + 128 * MiB;
constexpr size_t WS_RSTD = WS_SSQ + 1 * MiB;
constexpr size_t WS_DKV = WS_RSTD + 1 * MiB;
constexpr size_t WS_SKV = WS_DKV + 64 * MiB;
constexpr size_t WS_GVF = WS_SKV + 16 * MiB;
constexpr size_t WS_END = WS_GVF + 32 * MiB;
static_assert((size_t)NPROJ * D * 2 == 18 * MiB && (size_t)NUP * D * 2 == 44 * MiB && (size_t)D * DFF * 2 == 22 * MiB && (size_t)256 * NUP * 4 == 11 * MiB, "weight map");
static_assert(WS_END <= (size_t)1408 * MiB, "d_ws is at least 4 x ffn_w_up = 1408 MiB");
constexpr int PA_NMIX = 0, PA_NXA = 8192, PA_NFFN = 16384, PA_FIN = 24576, PA_LAM = 26624, PA_SUB = 27136, PA_SINK = 27392, PA_GB = 27456, PA_GNG = 28480, PA_CW = 28992, PA_CB = 164160, PA_PTRS = 209216  , PA_END = 209232;
static_assert((size_t)PA_END * 4 <= MiB, "parameter block");
constexpr int CW_BAR = 4096;

constexpr int RING_OFF = 0, RING_BYTES = 131072;
constexpr int XCH_OFF = RING_BYTES, XCH_BYTES = 8192;
constexpr int MISC_OFF = XCH_OFF + XCH_BYTES;
constexpr int LDS_BYTES = 147456;
static_assert(MISC_OFF + 128 <= LDS_BYTES, "LDS map");

#define GAS __attribute__((address_space(1)))
#define LAS __attribute__((address_space(3)))
typedef unsigned short bf16;
typedef unsigned v4u __attribute__((ext_vector_type(4)));
typedef unsigned v2u __attribute__((ext_vector_type(2)));
typedef float f32x4 __attribute__((ext_vector_type(4)));
typedef GAS unsigned gu32;
#define RLX_AGENT __ATOMIC_RELAXED, __HIP_MEMORY_SCOPE_AGENT
#define LDS_WAIT() asm volatile("s_waitcnt lgkmcnt(0)" ::: "memory")
__device__ __forceinline__ unsigned f2bf(float f) { unsigned u = __builtin_bit_cast(unsigned, f); return (u + 0x7fffu + ((u >> 16) & 1u)) >> 16; }
__device__ __forceinline__ unsigned pk2(float lo, float hi) { return f2bf(lo) | (f2bf(hi) << 16); }
__device__ __forceinline__ float bflo(unsigned w) { return __uint_as_float(w << 16); }
__device__ __forceinline__ float bfhi(unsigned w) { return __uint_as_float(w & 0xffff0000u); }
__device__ __forceinline__ float bf1(const bf16* p) { return __uint_as_float((unsigned)(*p) << 16); }
__device__ __forceinline__ float wave_sum(float v) {
#pragma unroll
    for (int o = 1; o < 64; o <<= 1) v += __shfl_xor(v, o);
    return v;
}

__host__ __device__ __forceinline__ size_t dkv_off(int b, int head, int kt, int f) { return ((((size_t)(b * 8 + head) * 64 + kt) * 8 + f) * 64) * 8; }
__host__ __device__ __forceinline__ size_t skv_off(int b, int g, int kt, int f) { return ((((size_t)(b * 2 + g) * 64 + kt) * 8 + f) * 64) * 8; }
__host__ __device__ __forceinline__ size_t gvf_off(int b, int head, int kt, int vq, int f) { return ((((((size_t)(b * 4 + head) * 64 + kt) * 4 + vq) * 2 + f) * 64)) * 8; }
__host__ __device__ __forceinline__ size_t xkv_off(int layer, int b, int head, int kt, int f) { return ((((((size_t)(layer * 16 + b) * 4 + head) * 8 + kt) * 16 + f) * 64)) * 8; }
namespace pg8 {
struct EpiProj {
    static constexpr bool PERM = true, AFTER_DRAIN = false;
    bf16_t* O; int ldc; const float* ssq; bf16_t* dkv; bf16_t* skv; bf16_t* gvf;
    __device__ __forceinline__ void operator()(f32x4 (&acc)[2][2][4][2], const Unit& u, int wr, int wc, int fr, int fq) const {
        { int l_ = threadIdx.x & 63; asm volatile("" : "+v"(l_)); fr = l_ & 15; fq = l_ >> 4; }
        const int row0 = u.pm * BM + wr * 64 + fr; const int col0 = u.pn * BM + wc * 32 + 8 * fq;
        const int pn = u.pn; const int kind = (pn >= 2 && pn <= 5) ? 1 : (pn == 10 ? 2 : ((pn == 13 || pn == 14) ? 3 : 0));
        const int hh = fq & 1, b = u.pm >> 3;
#pragma unroll
        for (int ai = 0; ai < 2; ++ai)
#pragma unroll
            for (int m = 0; m < 4; ++m) { const int row = row0 + ai * HALF + m * 16;
                const float rs = row_rstd(ssq, row);
                const int s = row & 2047, kt = s >> 5, ln = (s & 31) + 32 * hh;
#pragma unroll
                for (int bj = 0; bj < 2; ++bj) { const f32x4 v0 = acc[ai][bj][m][0] * rs, v1 = acc[ai][bj][m][1] * rs;
                    u32x4 w; w.x = cvt_pk_bf16(v0[0], v0[1]); w.y = cvt_pk_bf16(v0[2], v0[3]); w.z = cvt_pk_bf16(v1[0], v1[1]); w.w = cvt_pk_bf16(v1[2], v1[3]);
                    const int c = col0 + bj * HALF;
                    bf16_t* dst;
                    if (kind == 0) dst = O + (size_t)row * ldc + c;
                    else if (kind == 1) { const int isv = c >= 1024, cc = c - (isv ? 1024 : 512); dst = dkv + dkv_off(b, cc >> 6, kt, isv * 4 + ((cc & 63) >> 4)) + ln * 8; }
                    else if (kind == 2) { const int cc = c - 2560, isv = cc >> 7; dst = skv + skv_off(b, (cc & 127) >> 6, kt, isv * 4 + ((cc & 63) >> 4)) + ln * 8; }
                    else { const int cc = c - 3328; dst = gvf + gvf_off(b, cc >> 7, kt, (cc & 127) >> 5, (cc & 31) >> 4) + ln * 8; }
                    *(u32x4*)dst = w; } }
    }
};
struct EpiKvFrag {
    static constexpr bool PERM = true, AFTER_DRAIN = false;
    bf16_t* xkv;
    __device__ __forceinline__ void operator()(f32x4 (&acc)[2][2][4][2], const Unit& u, int wr, int wc, int fr, int fq) const {
        { int l_ = threadIdx.x & 63; asm volatile("" : "+v"(l_)); fr = l_ & 15; fq = l_ >> 4; }
        const int col0 = u.pn * BM + wc * 32 + 8 * fq; const int hh = fq & 1, b = u.pm;
#pragma unroll
        for (int ai = 0; ai < 2; ++ai)
#pragma unroll
            for (int m = 0; m < 4; ++m) { const int mrow = ai * HALF + wr * 64 + m * 16 + fr; const int kt = mrow >> 5, ln = (mrow & 31) + 32 * hh;
#pragma unroll
                for (int bj = 0; bj < 2; ++bj) { const f32x4 v0 = acc[ai][bj][m][0], v1 = acc[ai][bj][m][1];
                    u32x4 w; w.x = cvt_pk_bf16(v0[0], v0[1]); w.y = cvt_pk_bf16(v0[2], v0[3]); w.z = cvt_pk_bf16(v1[0], v1[1]); w.w = cvt_pk_bf16(v1[2], v1[3]);
                    const int c = col0 + bj * HALF; const int layer = c >> 10, within = c & 1023, isv = within >> 9, head = (within & 511) >> 7, d = within & 127;
                    *(u32x4*)(xkv + xkv_off(layer, b, head, kt, isv * 8 + (d >> 4)) + ln * 8) = w; } }
    }
};
}
#define XB_TMO      128
#define XB_XCNT(j)  (256  + 64 * (j))
#define XB_XSUB(j)  (1280 + 64 * (j))
#define XB_XGEN(j)  (2304 + 64 * (j))
#define XB_TOP      3328
#define XB_TOPGEN   3392
#define XCD_BAR_WORDS 3456
#define XB_SPIN_CAP (1u << 22)

__device__ __forceinline__ unsigned xb_ld(unsigned* p)              { return __hip_atomic_load(p, __ATOMIC_RELAXED, __HIP_MEMORY_SCOPE_AGENT); }
__device__ __forceinline__ unsigned xb_add(unsigned* p, unsigned v) { return __hip_atomic_fetch_add(p, v, __ATOMIC_RELAXED, __HIP_MEMORY_SCOPE_AGENT); }
__device__ __forceinline__ unsigned xb_xcc_id() { return (unsigned)__builtin_amdgcn_s_getreg((3 << 11) | 20) & 0xFu; }
#define XB_SPIN(cond, bar) do { unsigned _sp = 0; while (cond) { __builtin_amdgcn_s_sleep(1); \
    if ((++_sp & 255u) == 0u) { if (xb_ld(&(bar)[XB_TMO])) break; if (_sp > XB_SPIN_CAP) { atomicAdd(&(bar)[XB_TMO], 1u); break; } } } } while (0)

struct XcdBarrier {
    unsigned* bar; unsigned x;
    volatile LAS unsigned* st;
};

__device__ __forceinline__ XcdBarrier xcd_barrier_post(unsigned* bar, volatile LAS unsigned* st) {
    XcdBarrier b; b.bar = bar; b.x = xb_xcc_id(); b.st = st;
    if (threadIdx.x == 0) (void)xb_add(&bar[XB_XCNT(b.x)], 1u);
    return b;
}
__device__ __forceinline__ void xcd_barrier_complete(unsigned* bar, unsigned x, unsigned& nloc, unsigned& nx) {
    const unsigned G = gridDim.x * gridDim.y * gridDim.z;
    unsigned sum, cnt, mine, sp = 0u;
    for (;;) {
        sum = 0u; cnt = 0u; mine = 0u;
#pragma unroll
        for (unsigned j = 0; j < 16; ++j) { const unsigned c = xb_ld(&bar[XB_XCNT(j)]); sum += c; cnt += (c > 0u) ? 1u : 0u; mine = (j == x) ? c : mine; }
        if (sum == G) break;
        __builtin_amdgcn_s_sleep(1);
        if ((++sp & 255u) == 0u) { if (xb_ld(&bar[XB_TMO])) break; if (sp > XB_SPIN_CAP) { atomicAdd(&bar[XB_TMO], 1u); break; } }
    }
    nloc = mine > 0u ? mine : 1u; nx = cnt > 0u ? cnt : 1u;
}

__device__ __forceinline__ void xcd_barrier(const XcdBarrier& b) {
    asm volatile("s_waitcnt vmcnt(0)" ::: "memory");
    __syncthreads();
    if (threadIdx.x == 0) {
        __attribute__((address_space(1))) unsigned* barg_ = (__attribute__((address_space(1))) unsigned*)b.bar; unsigned bx_ = b.x;
        asm volatile("" : "+s"(barg_), "+s"(bx_));
        unsigned* bar = (unsigned*)barg_;
        __builtin_amdgcn_s_waitcnt(0);
        unsigned nloc = b.st[0], nx = b.st[1];
        if (nloc == 0u) { xcd_barrier_complete(bar, bx_, nloc, nx); b.st[0] = nloc; b.st[1] = nx; }
        const unsigned old = xb_add(&bar[XB_XSUB(bx_)], 1u);
        const unsigned gen = old / nloc;
        if (old + 1u == (gen + 1u) * nloc) {
            __builtin_amdgcn_fence(__ATOMIC_RELEASE, "agent");
            asm volatile("s_waitcnt vmcnt(0)" ::: "memory");
            const unsigned og = xb_add(&bar[XB_TOP], 1u);
            const unsigned tg = og / nx;
            if (og + 1u == (tg + 1u) * nx) xb_add(&bar[XB_TOPGEN], 1u);
            else XB_SPIN(xb_ld(&bar[XB_TOPGEN]) == tg, bar);
            __builtin_amdgcn_fence(__ATOMIC_ACQUIRE, "agent");
            xb_add(&bar[XB_XGEN(bx_)], 1u);
            asm volatile("s_waitcnt vmcnt(0)" ::: "memory");
        } else {
            XB_SPIN(xb_ld(&bar[XB_XGEN(bx_)]) == gen, bar);
            __builtin_amdgcn_fence(__ATOMIC_ACQUIRE, "agent");
            asm volatile("s_waitcnt vmcnt(0)" ::: "memory");
        }
    }
    __syncthreads();
}


__device__ __forceinline__ void transpose_item(const float* W, int ldn, int k0, int n0s, bf16* WT, int K, int n0d, LAS float* scr, int lane, const float* gk) {
    float wv[32], gv[32];
    { const float* wp = W + (size_t)(k0 + (lane >> 5)) * ldn + n0s + (lane & 31);
#pragma unroll
      for (int i = 0; i < 32; ++i) wv[i] = wp[(size_t)(2 * i) * ldn];
      if (gk) {
#pragma unroll
          for (int i = 0; i < 32; ++i) gv[i] = gk[k0 + 2 * i + (lane >> 5)]; }
    }
#pragma unroll
    for (int i = 0; i < 32; ++i) { const int kk = 2 * i + (lane >> 5); scr[kk * 33 + (lane & 31)] = gk ? wv[i] * gv[i] : wv[i]; }
    LDS_WAIT(); asm volatile("" ::: "memory");
    const int c = lane & 7;
#pragma unroll
    for (int j = 0; j < 4; ++j) { const int n = (lane >> 3) + 8 * j; const LAS float* s = scr + (8 * c) * 33 + n;
        v4u o; o.x = pk2(s[0 * 33], s[1 * 33]); o.y = pk2(s[2 * 33], s[3 * 33]); o.z = pk2(s[4 * 33], s[5 * 33]); o.w = pk2(s[6 * 33], s[7 * 33]);
        *(GAS v4u*)(WT + (size_t)(n0d + n) * K + k0 + 8 * c) = o; }
    LDS_WAIT(); asm volatile("" ::: "memory");
}

struct Ptrs {
    const float* in[22]; float* out; unsigned char* ws;
};
__device__ __forceinline__ bf16* wlp(unsigned char* ws, int l, size_t off) { return (bf16*)(ws + WS_W + (size_t)l * WL_STRIDE + off); }
__device__ __forceinline__ bf16* wl(const Ptrs& P, int l, size_t off) { return wlp(P.ws, l, off); }

__device__ __forceinline__ void rms_row_to_bf16(const float* xrow, const float* g, bf16* orow, bf16* orow2, int lane) {
    const GAS f32x4* xr = (const GAS f32x4*)xrow + lane;
    f32x4 v[8]; float s = 0.f;
#pragma unroll
    for (int j = 0; j < 8; ++j) { v[j] = xr[64 * j]; s += (v[j].x * v[j].x + v[j].y * v[j].y) + (v[j].z * v[j].z + v[j].w * v[j].w); }
    const float rstd = 1.0f / sqrtf(wave_sum(s) * (1.f / D) + EPS);
    GAS v2u* o8 = (GAS v2u*)orow + lane; GAS v2u* o82 = (GAS v2u*)orow2 + lane;
#pragma unroll
    for (int j = 0; j < 8; ++j) {
        f32x4 y = v[j] * rstd;
        if (g) y = y * ((const GAS f32x4*)g)[lane + 64 * j];
        v2u w; w.x = pk2(y.x, y.y); w.y = pk2(y.z, y.w);
        o8[64 * j] = w; if (orow2) o82[64 * j] = w;
    }
}
__device__ __forceinline__ void rms_row_final(const bf16* hrow, float* orow, const float* g, const float* ssq8, int lane) {
    const f32x4 a = *(const GAS f32x4*)ssq8, b = *(const GAS f32x4*)(ssq8 + 4);
    const float rstd = 1.0f / sqrtf(((a.x + a.y) + (a.z + a.w) + (b.x + b.y) + (b.z + b.w)) * (1.f / D) + EPS);
    const GAS v2u* hr = (const GAS v2u*)hrow + lane; GAS f32x4* o = (GAS f32x4*)orow + lane;
#pragma unroll
    for (int j = 0; j < 8; ++j) { const v2u w = hr[64 * j]; const f32x4 gg = ((const GAS f32x4*)g)[lane + 64 * j];
        f32x4 y; y.x = bflo(w.x) * rstd * gg.x; y.y = bfhi(w.x) * rstd * gg.y; y.z = bflo(w.y) * rstd * gg.z; y.w = bfhi(w.y) * rstd * gg.w; o[64 * j] = y; }
}
__device__ __forceinline__ void rms_row_final2(const bf16* h0, const bf16* h1, float* o0p, float* o1p, const float* g, const float* ssqa, const float* ssqb, int lane) {
    const f32x4 a0 = *(const GAS f32x4*)ssqa, b0 = *(const GAS f32x4*)(ssqa + 4), a1 = *(const GAS f32x4*)ssqb, b1 = *(const GAS f32x4*)(ssqb + 4);
    const GAS v2u* hr0 = (const GAS v2u*)h0 + lane; const GAS v2u* hr1 = (const GAS v2u*)h1 + lane;
    v2u w0[8], w1[8];
#pragma unroll
    for (int j = 0; j < 8; ++j) { w0[j] = hr0[64 * j]; w1[j] = hr1[64 * j]; }
    const float r0 = 1.0f / sqrtf(((a0.x + a0.y) + (a0.z + a0.w) + (b0.x + b0.y) + (b0.z + b0.w)) * (1.f / D) + EPS);
    const float r1 = 1.0f / sqrtf(((a1.x + a1.y) + (a1.z + a1.w) + (b1.x + b1.y) + (b1.z + b1.w)) * (1.f / D) + EPS);
    GAS f32x4* o0 = (GAS f32x4*)o0p + lane; GAS f32x4* o1 = (GAS f32x4*)o1p + lane;
#pragma unroll
    for (int j = 0; j < 8; ++j) { const f32x4 gg = ((const GAS f32x4*)g)[lane + 64 * j];
        f32x4 y; y.x = bflo(w0[j].x) * r0 * gg.x; y.y = bfhi(w0[j].x) * r0 * gg.y; y.z = bflo(w0[j].y) * r0 * gg.z; y.w = bfhi(w0[j].y) * r0 * gg.w; o0[64 * j] = y;
        f32x4 z; z.x = bflo(w1[j].x) * r1 * gg.x; z.y = bfhi(w1[j].x) * r1 * gg.y; z.z = bflo(w1[j].y) * r1 * gg.z; z.w = bfhi(w1[j].y) * r1 * gg.w; o1[64 * j] = z; }
}

constexpr int TI_INA = 32 * 120, TI_INB = 32 * 16, TI_OUT = 32 * 64, TI_XQ = 32 * 16, TI_KV = 32 * 32, TI_XO = 8 * 64, TI_UP = 32 * 352, TI_DN = 88 * 64;
constexpr int TI_LAYER = TI_INA + TI_INB + TI_OUT + TI_XQ + TI_KV + TI_XO + TI_UP + TI_DN;
struct WSrc { const float* w_in; const float* w_out; const float* xa_wq; const float* xa_wo; const float* w_up; const float* w_dn; const float* g_mix; const float* g_xa; const float* g_ffn; };
constexpr int TI_LAYER_NOKV = TI_LAYER - TI_KV;
__device__ __forceinline__ void convert_layer_item(const WSrc& W, unsigned char* ws, int l, int r, LAS float* scr, int lane) {
    if (r < TI_INA) { const int kb = r / 120, nb = r % 120; transpose_item(W.w_in + (size_t)l * D * WIN_LD, WIN_LD, 64 * kb, 32 * nb, wlp(ws, l, WO_IN), D, 32 * nb, scr, lane, W.g_mix + (size_t)l * D); return; } r -= TI_INA;
    if (r < TI_INB) { const int kb = r / 16, nb = r % 16; transpose_item(W.w_in + (size_t)l * D * WIN_LD, WIN_LD, 64 * kb, 3856 + 32 * nb, wlp(ws, l, WO_IN), D, C_OG + 32 * nb, scr, lane, W.g_mix + (size_t)l * D); return; } r -= TI_INB;
    if (r < TI_OUT) { const int kb = r / 64, nb = r % 64; transpose_item(W.w_out + (size_t)l * D * D, D, 64 * kb, 32 * nb, wlp(ws, l, WO_OUT), D, 32 * nb, scr, lane, nullptr); return; } r -= TI_OUT;
    if (r < TI_XQ) { const int kb = r / 16, nb = r % 16; transpose_item(W.xa_wq + (size_t)l * D * DXA, DXA, 64 * kb, 32 * nb, wlp(ws, l, WO_XQ), D, 32 * nb, scr, lane, W.g_xa + (size_t)l * D); return; } r -= TI_XQ;
    if (r < TI_XO) { const int kb = r / 64, nb = r % 64; transpose_item(W.xa_wo + (size_t)l * DXA * D, D, 64 * kb, 32 * nb, wlp(ws, l, WO_XO), DXA, 32 * nb, scr, lane, nullptr); return; } r -= TI_XO;
    if (r < TI_UP) { const int kb = r / 352, nb = r % 352; const int pn = nb >> 3, w8 = nb & 7, bj = w8 >> 2, cc = (w8 & 3) * 32;
        transpose_item(W.w_up + (size_t)l * D * NUP, NUP, 64 * kb, bj * DFF + 128 * pn + cc, wlp(ws, l, WO_UP), D, 32 * nb, scr, lane, W.g_ffn + (size_t)l * D); return; } r -= TI_UP;
    { const int kb = r / 64, nb = r % 64; transpose_item(W.w_dn + (size_t)l * DFF * D, D, 64 * kb, 32 * nb, wlp(ws, l, WO_DN), DFF, 32 * nb, scr, lane, nullptr); }
}
__device__ __forceinline__ void prologue_phase(const Ptrs& P, LAS unsigned char* lds, int gw, int ngw, int wave, int lane) {
    LAS float* scr = (LAS float*)(lds + RING_OFF + wave * 16384);
    { const WSrc W{P.in[3], P.in[10], P.in[13], P.in[15], P.in[17], P.in[20], P.in[2], P.in[11], P.in[16]};
      for (int it = gw; it < TI_LAYER_NOKV + NLAYER * TI_KV; it += ngw) {
          if (it < TI_LAYER_NOKV) { convert_layer_item(W, P.ws, 0, it, scr, lane); continue; }
          const int r2 = it - TI_LAYER_NOKV, l = r2 / TI_KV, r = r2 % TI_KV, kb = r / 32, nb = r % 32;
          transpose_item(P.in[14] + (size_t)l * D * 1024, 1024, 64 * kb, 32 * nb, (bf16*)(P.ws + WS_WKV), D, l * 1024 + 32 * nb, scr, lane, P.in[12] + (size_t)l * D);
      }
      if (gw == 0 && lane == 0) { unsigned long long* pp = (unsigned long long*)(P.ws + WS_PAR + PA_PTRS * 4);
          pp[0] = (unsigned long long)P.in[3]; pp[1] = (unsigned long long)P.in[10]; pp[2] = (unsigned long long)P.in[13]; pp[3] = (unsigned long long)P.in[15]; pp[4] = (unsigned long long)P.in[17]; pp[5] = (unsigned long long)P.in[20]; }
    }
    for (int it = gw; it < NLAYER * 32 * 8; it += ngw) {
        const int l = it >> 8, k = (((it >> 3) & 31) << 6) + lane, n0 = (it & 7) * 32;
        const float* src = P.in[3] + (size_t)l * D * WIN_LD + (size_t)k * WIN_LD + 3840;
        float a[16];
#pragma unroll
        for (int q = 0; q < 4; ++q) { const f32x4 t = *(const GAS f32x4*)(src + 4 * q); a[4 * q] = t.x; a[4 * q + 1] = t.y; a[4 * q + 2] = t.z; a[4 * q + 3] = t.w; }
        { const float gk = P.in[2][(size_t)l * D + k];
#pragma unroll
          for (int r = 0; r < 16; ++r) a[r] *= gk; }
        const float* w2 = P.in[7] + (size_t)l * 16 * 256;
        bf16* dst = wl(P, l, WO_IN) + (size_t)C_Z * D + k;
        for (int n = n0; n < n0 + 32; ++n) { float s = 0.f;
#pragma unroll
            for (int r = 0; r < 16; ++r) s += a[r] * w2[r * 256 + n];
            dst[(size_t)n * D] = (bf16)f2bf(s); }
    }
    { float* PA = (float*)(P.ws + WS_PAR); const int i0 = gw * 64 + lane, st = ngw * 64;
#define CPY(off, src, n) for (int i = i0; i < (n); i += st) PA[(off) + i] = (src)[i]
      CPY(PA_NMIX, P.in[2], NLAYER * D); CPY(PA_NXA, P.in[11], NLAYER * D); CPY(PA_NFFN, P.in[16], NLAYER * D); CPY(PA_FIN, P.in[21], D);
      CPY(PA_LAM, P.in[4], NLAYER * 128); CPY(PA_SUB, P.in[5], NLAYER * 64); CPY(PA_SINK, P.in[6], NLAYER * 16); CPY(PA_GB, P.in[8], NLAYER * 256); CPY(PA_GNG, P.in[9], NLAYER * 128);
      CPY(PA_CW, P.in[18], NLAYER * 3 * NUP); CPY(PA_CB, P.in[19], NLAYER * NUP);
#undef CPY
    }
    for (int r = gw; r < MROWS; r += ngw) rms_row_to_bf16(P.in[1] + (size_t)r * D, nullptr, (bf16*)(P.ws + WS_MEMN) + (size_t)r * D, nullptr, lane);
    for (int r = gw; r < T; r += ngw) {
        const GAS f32x4* xr = (const GAS f32x4*)(P.in[0] + (size_t)r * D) + lane; GAS v2u* o8 = (GAS v2u*)((bf16*)(P.ws + WS_HB) + (size_t)r * D) + lane;
        float s = 0.f;
#pragma unroll
        for (int j = 0; j < 8; ++j) { const f32x4 v = xr[64 * j]; s += (v.x * v.x + v.y * v.y) + (v.z * v.z + v.w * v.w); v2u w; w.x = pk2(v.x, v.y); w.y = pk2(v.z, v.w); o8[64 * j] = w; }
        s = wave_sum(s);
        if (lane < 8) ((float*)(P.ws + WS_SSQ))[(size_t)r * 8 + lane] = lane == 0 ? s : 0.f;
    }
}

__device__ __forceinline__ void gla_finish_row(const bf16* PROJ, const float* OGLA, bf16* MIX, const float* gng, int r, int lane) {
    const int hh = lane >> 4, sub = lane & 15;
    const float* src = OGLA + (size_t)r * 512 + hh * 128 + sub * 8;
    const f32x4 o0 = *(const GAS f32x4*)src, o1 = *(const GAS f32x4*)(src + 4);
    float ss = (o0.x * o0.x + o0.y * o0.y) + (o0.z * o0.z + o0.w * o0.w) + (o1.x * o1.x + o1.y * o1.y) + (o1.z * o1.z + o1.w * o1.w);
    ss += __shfl_xor(ss, 1); ss += __shfl_xor(ss, 2); ss += __shfl_xor(ss, 4); ss += __shfl_xor(ss, 8);
    const float rr = __builtin_amdgcn_rsqf(ss * (1.f / 128.f) + EPS);
    const v4u ogw = *(const GAS v4u*)(PROJ + (size_t)r * NPROJ + C_OG + hh * 128 + sub * 8);
    float og[8] = {bflo(ogw.x), bfhi(ogw.x), bflo(ogw.y), bfhi(ogw.y), bflo(ogw.z), bfhi(ogw.z), bflo(ogw.w), bfhi(ogw.w)};
    float ov[8] = {o0.x, o0.y, o0.z, o0.w, o1.x, o1.y, o1.z, o1.w};
    float y[8];
#pragma unroll
    for (int i = 0; i < 8; ++i) { const float sg = og[i] * __builtin_amdgcn_rcpf(1.0f + __builtin_amdgcn_exp2f(og[i] * -1.4426950408889634f)); y[i] = ov[i] * rr * gng[sub * 8 + i] * sg; }
    v4u w; w.x = pk2(y[0], y[1]); w.y = pk2(y[2], y[3]); w.z = pk2(y[4], y[5]); w.w = pk2(y[6], y[7]);
    *(GAS v4u*)(MIX + (size_t)r * D + M_GLA + hh * 128 + sub * 8) = w;
}
__device__ __forceinline__ void gla_finish_row2(const bf16* PROJ, const float* OGLA, bf16* MIX, const float* gng, int ra, int rb, int lane) {
    const int hh = lane >> 4, sub = lane & 15;
    const float* sa = OGLA + (size_t)ra * 512 + hh * 128 + sub * 8; const float* sb = OGLA + (size_t)rb * 512 + hh * 128 + sub * 8;
    const f32x4 oa0 = *(const GAS f32x4*)sa, oa1 = *(const GAS f32x4*)(sa + 4), ob0 = *(const GAS f32x4*)sb, ob1 = *(const GAS f32x4*)(sb + 4);
    const v4u ga = *(const GAS v4u*)(PROJ + (size_t)ra * NPROJ + C_OG + hh * 128 + sub * 8), gb = *(const GAS v4u*)(PROJ + (size_t)rb * NPROJ + C_OG + hh * 128 + sub * 8);
    const f32x4 n0 = *(const GAS f32x4*)(gng + sub * 8), n1 = *(const GAS f32x4*)(gng + sub * 8 + 4);
    const float gn[8] = {n0.x, n0.y, n0.z, n0.w, n1.x, n1.y, n1.z, n1.w};
#pragma unroll
    for (int k = 0; k < 2; ++k) { const f32x4 o0 = k ? ob0 : oa0, o1 = k ? ob1 : oa1; const v4u ogw = k ? gb : ga; const int r = k ? rb : ra;
        float ss = (o0.x * o0.x + o0.y * o0.y) + (o0.z * o0.z + o0.w * o0.w) + (o1.x * o1.x + o1.y * o1.y) + (o1.z * o1.z + o1.w * o1.w);
        ss += __shfl_xor(ss, 1); ss += __shfl_xor(ss, 2); ss += __shfl_xor(ss, 4); ss += __shfl_xor(ss, 8);
        const float rr = __builtin_amdgcn_rsqf(ss * (1.f / 128.f) + EPS);
        const float og[8] = {bflo(ogw.x), bfhi(ogw.x), bflo(ogw.y), bfhi(ogw.y), bflo(ogw.z), bfhi(ogw.z), bflo(ogw.w), bfhi(ogw.w)};
        const float ov[8] = {o0.x, o0.y, o0.z, o0.w, o1.x, o1.y, o1.z, o1.w};
        float y[8];
#pragma unroll
        for (int i = 0; i < 8; ++i) { const float sg = og[i] * __builtin_amdgcn_rcpf(1.0f + __builtin_amdgcn_exp2f(og[i] * -1.4426950408889634f)); y[i] = ov[i] * rr * gn[i] * sg; }
        v4u w; w.x = pk2(y[0], y[1]); w.y = pk2(y[2], y[3]); w.z = pk2(y[4], y[5]); w.w = pk2(y[6], y[7]);
        *(GAS v4u*)(MIX + (size_t)r * D + M_GLA + hh * 128 + sub * 8) = w; }
}


typedef short bf16x8 __attribute__((ext_vector_type(8)));
typedef float f32x16 __attribute__((ext_vector_type(16)));
#define MFMA32(a, b, c) __builtin_amdgcn_mfma_f32_32x32x16_bf16((a), (b), (c), 0, 0, 0)
constexpr float LOG2E = 1.4426950408889634f;
__device__ __forceinline__ bf16x8 ldf(const bf16* p) { return *(const GAS bf16x8*)p; }
typedef float f32x2_t __attribute__((ext_vector_type(2))); typedef __bf16 bf16x2_t __attribute__((ext_vector_type(2)));
__device__ __forceinline__ unsigned cvtpk(float lo, float hi) { f32x2_t v = {lo, hi}; bf16x2_t b = __builtin_convertvector(v, bf16x2_t); return __builtin_bit_cast(unsigned, b); }
__device__ __forceinline__ void acc2frag(const f32x16& x, bf16x8& f0, bf16x8& f1) {
    v4u a, b;
    a.x = cvtpk(x[0], x[1]); a.y = cvtpk(x[2], x[3]); a.z = cvtpk(x[4], x[5]); a.w = cvtpk(x[6], x[7]);
    b.x = cvtpk(x[8], x[9]); b.y = cvtpk(x[10], x[11]); b.z = cvtpk(x[12], x[13]); b.w = cvtpk(x[14], x[15]);
    f0 = __builtin_bit_cast(bf16x8, a); f1 = __builtin_bit_cast(bf16x8, b);
}
typedef unsigned u32x2p __attribute__((ext_vector_type(2)));
__device__ __forceinline__ void store_pair16(bf16* orow, int h, int k, v2u a, v2u b) {
    const u32x2p rx = __builtin_amdgcn_permlane32_swap(a.x, b.x, false, false), ry = __builtin_amdgcn_permlane32_swap(a.y, b.y, false, false);
    v4u w; w.x = rx[0]; w.y = ry[0]; w.z = rx[1]; w.w = ry[1];
    *(GAS v4u*)(orow + 8 * (k + h)) = w;
}
__device__ __forceinline__ f32x16 zero16() { f32x16 z;
#pragma unroll
    for (int i = 0; i < 16; ++i) z[i] = 0.f;
    return z; }
__device__ __forceinline__ void make_idf(bf16x8 (&idf)[2], int lane) {
    const int c = lane & 31, h = lane >> 5;
#pragma unroll
    for (int q = 0; q < 2; ++q)
#pragma unroll
        for (int j = 0; j < 8; ++j) idf[q][j] = ((16 * q + 8 * h + j) == c) ? (short)0x3F80 : (short)0;
}
#define SROW(i, h) (((i) & 3) + 8 * ((i) >> 2) + 4 * (h))


#define SOFTMAX_LAZY(x, xoff, mref, lrun, OT, NV, pf0, pf1) do { \
    float tm_ = fmaxf(fmaxf(x[0], x[1]), fmaxf(x[2], x[3])); \
    _Pragma("unroll") for (int i_ = 4; i_ < 16; i_ += 4) tm_ = fmaxf(tm_, fmaxf(fmaxf(x[i_], x[i_ + 1]), fmaxf(x[i_ + 2], x[i_ + 3]))); \
    if (__any(tm_ > 6.0f)) { \
        tm_ = fmaxf(tm_, __shfl_xor(tm_, 32)); \
        const float d_ = fmaxf(tm_, 0.f); const float corr_ = __builtin_amdgcn_exp2f(-d_); \
        mref += d_; xoff -= d_; lrun *= corr_; \
        _Pragma("unroll") for (int i_ = 0; i_ < 16; ++i_) x[i_] -= d_; \
        _Pragma("unroll") for (int v_ = 0; v_ < (NV); ++v_) OT[v_] = OT[v_] * corr_; \
    } \
    f32x16 p_; float ps_ = 0.f; \
    _Pragma("unroll") for (int i_ = 0; i_ < 16; ++i_) { p_[i_] = __builtin_amdgcn_exp2f(x[i_]); ps_ += p_[i_]; } \
    lrun += ps_; \
    acc2frag(p_, pf0, pf1); } while (0)


constexpr int DRING_STAGES = 8, DRING_STAGE_BYTES = 8192, DRAW_OFF = 65536, DRAW_BYTES = 4096;
#define MIXW_WAIT_V(n) asm volatile("s_waitcnt vmcnt(" #n ")" ::: "memory")
__device__ __forceinline__ void diff_wg_item(LAS unsigned char* ring, const bf16* PROJ, const bf16* DKV, bf16* MIX, int b, int hd, int QB, float lam_full, float one_m_li, const float* subg, int lane, int wave) {
    const int tl = lane & 31, h = lane >> 5;
    const int qb = QB * 8 + wave, ktop = QB * 8 + 7;
    const size_t row0 = (size_t)b * SEQ;
    const bf16* qrow = PROJ + (row0 + qb * 32 + tl) * NPROJ + C_DQ + hd * 64 + 8 * h;
    bf16x8 qf[2][2];
#pragma unroll
    for (int m = 0; m < 2; ++m)
#pragma unroll
        for (int q = 0; q < 2; ++q) qf[m][q] = ldf(qrow + m * 32 + 16 * q);
    bf16x8 idf[2]; make_idf(idf, lane);
    const float slope2 = exp2f(-(float)(hd + 1)) * LOG2E, c1 = 0.17677669529663687f * LOG2E;
    float cst[16];
#pragma unroll
    for (int i = 0; i < 16; ++i) cst[i] = slope2 * (float)((i & 3) + 8 * (i >> 2));
    f32x16 O0[2], O1[2];
    O0[0] = zero16(); O0[1] = zero16(); O1[0] = zero16(); O1[1] = zero16();
    float m0 = 0.f, m1 = 0.f, l0 = 0.f, l1 = 0.f;
    float off0 = slope2 * (float)(4 * h - tl) - m0, off1 = off0;
    const float dstep = -32.f * slope2;
    const char* gsrc = (const char*)(DKV + dkv_off(b, hd, 0, wave)) + lane * 16;
    LAS unsigned char* dmy = ring + (wave < 4 ? wave * 1024 : DRAW_OFF + (wave - 4) * 1024);
    const int dstride = wave < 4 ? DRING_STAGE_BYTES : DRAW_BYTES;
    const LAS unsigned char* rd = ring + lane * 16;
#define DIFF_ISSUE(KT) __builtin_amdgcn_global_load_lds((const unsigned*)(gsrc + (size_t)(KT) * 8192), (LAS unsigned*)(dmy + ((KT) & 7) * dstride), 16, 0, 0)
#define DIFF_VT(T) do { if ((wave & 6) == (((T) & 3) << 1)) { const int vt_ = wave & 1; const LAS unsigned char* rp = rd + DRAW_OFF + ((T) & 7) * DRAW_BYTES + vt_ * 2048; \
        f32x16 vc = MFMA32(*(const LAS bf16x8*)(rp), idf[0], zero16()); vc = MFMA32(*(const LAS bf16x8*)(rp + 1024), idf[1], vc); bf16x8 a0, a1; acc2frag(vc, a0, a1); \
        LAS unsigned char* wp = ring + ((T) & 7) * DRING_STAGE_BYTES + 4096 + vt_ * 2048 + lane * 16; *(LAS bf16x8*)(wp) = a0; *(LAS bf16x8*)(wp + 1024) = a1; } } while (0)
#define DIFFW_WAITN(n) asm volatile("s_waitcnt vmcnt(" #n ") lgkmcnt(0)" ::: "memory")
#define DIFFW_SYNC() do { if (kt >= 6) DIFFW_WAITN(5); else if (kt == 5) DIFFW_WAITN(4); else if (kt == 4) DIFFW_WAITN(3); else if (kt == 3) DIFFW_WAITN(2); else if (kt == 2) DIFFW_WAITN(1); else DIFFW_WAITN(0); \
        __builtin_amdgcn_s_barrier(); if (kt >= 7) DIFF_ISSUE(kt - 7); if (kt >= 1) DIFF_VT(kt - 1); } while (0)
#define DIFFW_SCORES(KT, D0, D1) do { const LAS unsigned char* spk = rd + ((KT) & 7) * DRING_STAGE_BYTES; \
        const bf16x8 k00 = *(const LAS bf16x8*)(spk), k01 = *(const LAS bf16x8*)(spk + 1024), k10 = *(const LAS bf16x8*)(spk + 2048), k11 = *(const LAS bf16x8*)(spk + 3072); \
        D0 = MFMA32(k00, qf[0][0], zero16()); D1 = MFMA32(k10, qf[1][0], zero16()); D0 = MFMA32(k01, qf[0][1], D0); D1 = MFMA32(k11, qf[1][1], D1); } while (0)
#define MX3(a, b, c) __builtin_fmaxf(__builtin_fmaxf((a), (b)), (c))
#define MAX16(v) __builtin_fmaxf(MX3(MX3(MX3(v[0], v[1], v[2]), v[3], v[4]), MX3(v[5], v[6], v[7]), MX3(v[8], v[9], v[10])), MX3(MX3(v[11], v[12], v[13]), v[14], v[15]))
#define DIFFW_TILE(MASKED) do { \
        f32x16 n0, n1; DIFFW_SCORES(kt - 1, n0, n1);                   \
        const float bnd0 = MAX16(sA0) * c1 + (cmax + off0), bnd1 = MAX16(sA1) * c1 + (cmax + off1); \
        if ((MASKED) || __any(fmaxf(bnd0, bnd1) > -60.0f)) { \
        const LAS unsigned char* spv = rd + (kt & 7) * DRING_STAGE_BYTES + 4096; \
        const bf16x8 a00 = *(const LAS bf16x8*)(spv), a01 = *(const LAS bf16x8*)(spv + 1024), a10 = *(const LAS bf16x8*)(spv + 2048), a11 = *(const LAS bf16x8*)(spv + 3072); \
        float x0[16], x1[16]; \
        _Pragma("unroll") for (int i = 0; i < 16; ++i) { const float t0 = sA0[i] * c1 + cst[i], t1 = sA1[i] * c1 + cst[i]; x0[i] = t0 + off0; x1[i] = t1 + off1; \
            if ((MASKED) && SROW(i, h) > tl) { x0[i] = -1e30f; x1[i] = -1e30f; } } \
        if (__builtin_expect(__any(fmaxf(bnd0, bnd1) > 6.0f), 0)) { \
            float tm0 = MAX16(x0), tm1 = MAX16(x1); \
            if (__any(fmaxf(tm0, tm1) > 6.0f)) { \
            tm0 = fmaxf(tm0, __shfl_xor(tm0, 32)); tm1 = fmaxf(tm1, __shfl_xor(tm1, 32)); \
            const float d0 = fmaxf(tm0, 0.f), d1 = fmaxf(tm1, 0.f); const float cr0 = __builtin_amdgcn_exp2f(-d0), cr1 = __builtin_amdgcn_exp2f(-d1); \
            m0 += d0; m1 += d1; off0 -= d0; off1 -= d1; l0 *= cr0; l1 *= cr1; \
            _Pragma("unroll") for (int i = 0; i < 16; ++i) { x0[i] -= d0; x1[i] -= d1; } \
            O0[0] = O0[0] * cr0; O0[1] = O0[1] * cr0; O1[0] = O1[0] * cr1; O1[1] = O1[1] * cr1; } \
        } \
        f32x16 p0, p1; float ps0 = 0.f, ps1 = 0.f; \
        _Pragma("unroll") for (int i = 0; i < 16; ++i) { p0[i] = __builtin_amdgcn_exp2f(x0[i]); p1[i] = __builtin_amdgcn_exp2f(x1[i]); ps0 += p0[i]; ps1 += p1[i]; } \
        l0 += ps0; l1 += ps1; \
        bf16x8 pf00, pf01, pf10, pf11; \
        acc2frag(p0, pf00, pf01); acc2frag(p1, pf10, pf11); \
        O0[0] = MFMA32(a00, pf00, O0[0]); O0[1] = MFMA32(a10, pf00, O0[1]); O1[0] = MFMA32(a00, pf10, O1[0]); O1[1] = MFMA32(a10, pf10, O1[1]); \
        O0[0] = MFMA32(a01, pf01, O0[0]); O0[1] = MFMA32(a11, pf01, O0[1]); O1[0] = MFMA32(a01, pf11, O1[0]); O1[1] = MFMA32(a11, pf11, O1[1]); \
        } \
        sA0 = n0; sA1 = n1; off0 += dstep; off1 += dstep; } while (0)
    const float cmax = 27.f * slope2;
    DIFF_ISSUE(ktop); DIFF_ISSUE(ktop - 1); DIFF_ISSUE(ktop - 2); DIFF_ISSUE(ktop - 3); DIFF_ISSUE(ktop - 4); DIFF_ISSUE(ktop - 5);
    f32x16 sA0, sA1;
    int kt = ktop + 1;
    for (; kt > qb + 1; --kt) DIFFW_SYNC();
    { DIFFW_SYNC(); DIFFW_SCORES(qb, sA0, sA1); --kt; }
    { DIFFW_SYNC(); DIFFW_TILE(true); }
    for (kt = qb - 1; kt >= 0; --kt) { DIFFW_SYNC(); DIFFW_TILE(false); }
#undef DIFFW_SYNC
#undef DIFFW_WAITN
#undef DIFFW_SCORES
#undef DIFFW_TILE
#undef MAX16
#undef MX3
#undef DIFF_ISSUE
#undef DIFF_VT
    l0 += __shfl_xor(l0, 32); l1 += __shfl_xor(l1, 32);
    const float i0 = 1.0f / l0, i1 = lam_full / l1;
    float ss = 0.f;
#pragma unroll
    for (int vt = 0; vt < 2; ++vt)
#pragma unroll
        for (int i = 0; i < 16; ++i) { const float v = O0[vt][i] * i0 - O1[vt][i] * i1; O0[vt][i] = v; ss += v * v; }
    ss += __shfl_xor(ss, 32);
    const float r = one_m_li / sqrtf(ss * (1.f / 64.f) + EPS);
    bf16* orow = MIX + (row0 + qb * 32 + tl) * D + M_DIFF + hd * 64;
#pragma unroll
    for (int vt = 0; vt < 2; ++vt)
#pragma unroll
        for (int k = 0; k < 4; k += 2) { v2u w[2];
#pragma unroll
            for (int e = 0; e < 2; ++e) { const int v0 = 32 * vt + 8 * (k + e) + 4 * h; const f32x4 g = *(const GAS f32x4*)(subg + v0);
                w[e].x = cvtpk(O0[vt][4 * (k + e)] * r * g.x, O0[vt][4 * (k + e) + 1] * r * g.y); w[e].y = cvtpk(O0[vt][4 * (k + e) + 2] * r * g.z, O0[vt][4 * (k + e) + 3] * r * g.w); }
            store_pair16(orow + 32 * vt, h, k, w[0], w[1]); }
}


constexpr int SW_STAGE = 8192, SW_RAW_OFF = 65536, SW_RAW = 4096;
__device__ __forceinline__ void swa_wg_item(LAS unsigned char* ring, const bf16* PROJ, const bf16* SKV, bf16* MIX, int b, int g, int qb0, float sink, int lane, int wave) {
    const int tl = lane & 31, h = lane >> 5, hq = g * 8 + wave, qbl = qb0 + 7;
    const size_t row0 = (size_t)b * SEQ;
    bf16x8 idf[2]; make_idf(idf, lane);
    const float slope2 = exp2f(-0.5f * (float)(hq + 1)) * LOG2E, c1 = 0.125f * LOG2E;
    float cst[16];
#pragma unroll
    for (int i = 0; i < 16; ++i) cst[i] = slope2 * (float)((i & 3) + 8 * (i >> 2));
    const float dstep = -32.f * slope2;
    const char* gsrc = (const char*)(SKV + skv_off(b, g, 0, wave)) + lane * 16;
    LAS unsigned char* dmy = ring + (wave < 4 ? wave * 1024 : SW_RAW_OFF + (wave - 4) * 1024);
    const int dstride = wave < 4 ? SW_STAGE : SW_RAW;
    const LAS unsigned char* rd = ring + lane * 16;
#define SWA_ISSUE(T) __builtin_amdgcn_global_load_lds((const unsigned*)(gsrc + (size_t)(T) * 8192), (LAS unsigned*)(dmy + ((T) & 7) * dstride), 16, 0, 0)
#define SWA_VT(T) do { if ((wave & 6) == (((T) & 3) << 1)) { const int vt_ = wave & 1; const LAS unsigned char* rp = rd + SW_RAW_OFF + ((T) & 7) * SW_RAW + vt_ * 2048; \
        f32x16 vc = MFMA32(*(const LAS bf16x8*)(rp), idf[0], zero16()); vc = MFMA32(*(const LAS bf16x8*)(rp + 1024), idf[1], vc); bf16x8 a0, a1; acc2frag(vc, a0, a1); \
        LAS unsigned char* wp = ring + ((T) & 7) * SW_STAGE + 4096 + vt_ * 2048 + lane * 16; *(LAS bf16x8*)(wp) = a0; *(LAS bf16x8*)(wp + 1024) = a1; } } while (0)
    const int t0 = qb0 >= 4 ? qb0 - 4 : 0;
    for (int t = t0; t <= qb0 + 1; ++t) SWA_ISSUE(t);
    asm volatile("" ::: "memory");
    bf16x8 qn[4];
    { const bf16* qrow = PROJ + (row0 + qb0 * 32 + tl) * NPROJ + C_SQ + hq * 64 + 8 * h;
#pragma unroll
      for (int q = 0; q < 4; ++q) qn[q] = ldf(qrow + 16 * q); }
    asm volatile("s_waitcnt vmcnt(0)" ::: "memory");
    __builtin_amdgcn_s_barrier();
    for (int t = t0; t <= qb0; ++t) SWA_VT(t);
    for (int qb = qb0; qb <= qbl; ++qb) {
        bf16x8 qf[4];
#pragma unroll
        for (int q = 0; q < 4; ++q) { qf[q] = qn[q]; asm volatile("" :: "v"(qf[q])); }
        asm volatile("s_waitcnt lgkmcnt(0)" ::: "memory");
        __builtin_amdgcn_s_barrier();
        if (qb + 2 <= qbl) SWA_ISSUE(qb + 2);
        asm volatile("" ::: "memory");
        if (qb < qbl) { const bf16* qrow = PROJ + (row0 + (qb + 1) * 32 + tl) * NPROJ + C_SQ + hq * 64 + 8 * h;
#pragma unroll
            for (int q = 0; q < 4; ++q) qn[q] = ldf(qrow + 16 * q);
            SWA_VT(qb + 1); }
        f32x16 O[2]; O[0] = zero16(); O[1] = zero16();
        float mr = sink * LOG2E, lr = (h == 0) ? 1.f : 0.f;
        float off = slope2 * (float)(4 * h - tl) - mr;
        const int kt0 = qb >= 4 ? qb - 4 : 0;
#define SWAW_TILE(MODE) do { \
            const LAS unsigned char* sp = rd + (kt & 7) * SW_STAGE; \
            f32x16 sc = MFMA32(*(const LAS bf16x8*)(sp), qf[0], zero16()); \
            _Pragma("unroll") for (int q = 1; q < 4; ++q) sc = MFMA32(*(const LAS bf16x8*)(sp + q * 1024), qf[q], sc); \
            const bf16x8 va0 = *(const LAS bf16x8*)(sp + 4096), va1 = *(const LAS bf16x8*)(sp + 5120), vb0 = *(const LAS bf16x8*)(sp + 6144), vb1 = *(const LAS bf16x8*)(sp + 7168); \
            float x[16]; \
            _Pragma("unroll") for (int i = 0; i < 16; ++i) { x[i] = (sc[i] * c1 + cst[i]) + off; if (((MODE) == 1 && SROW(i, h) > tl) || ((MODE) == 2 && SROW(i, h) <= tl)) x[i] = -1e30f; } \
            bf16x8 pf0, pf1; SOFTMAX_LAZY(x, off, mr, lr, O, 2, pf0, pf1); \
            O[0] = MFMA32(va0, pf0, O[0]); O[1] = MFMA32(vb0, pf0, O[1]); O[0] = MFMA32(va1, pf1, O[0]); O[1] = MFMA32(vb1, pf1, O[1]); \
            off += dstep; } while (0)
        int kt = qb;
        SWAW_TILE(1);
        for (kt = qb - 1; kt > qb - 4 && kt >= 0; --kt) SWAW_TILE(0);
        if (qb >= 4) { kt = qb - 4; SWAW_TILE(2); }
#undef SWAW_TILE
        lr += __shfl_xor(lr, 32);
        const float il = 1.0f / lr;
        bf16* orow = MIX + (row0 + qb * 32 + tl) * D + M_SWA + hq * 64;
#pragma unroll
        for (int vt = 0; vt < 2; ++vt)
#pragma unroll
            for (int k = 0; k < 4; k += 2) { v2u w[2];
#pragma unroll
                for (int e = 0; e < 2; ++e) { w[e].x = cvtpk(O[vt][4 * (k + e)] * il, O[vt][4 * (k + e) + 1] * il); w[e].y = cvtpk(O[vt][4 * (k + e) + 2] * il, O[vt][4 * (k + e) + 3] * il); }
                store_pair16(orow + 32 * vt, h, k, w[0], w[1]); }
    }
#undef SWA_ISSUE
#undef SWA_VT
}


__device__ __forceinline__ void xatt_wg_item(LAS unsigned char* ring, const bf16* QXA, const bf16* KVMEM, bf16* OXA, int layer, int b, int hd, int part, int lane, int wave) {
    const int tl = lane & 31, h = lane >> 5;
    const char* gsrc = (const char*)(KVMEM + xkv_off(layer, b, hd, 0, 0)) + wave * 1024 + lane * 16;
    LAS unsigned char* dmy = ring + wave * 1024;
#pragma unroll
    for (int i = 0; i < 16; ++i) __builtin_amdgcn_global_load_lds((const unsigned*)(gsrc + i * 8192), (LAS unsigned*)(dmy + i * 8192), 16, 0, 0);
    asm volatile("" ::: "memory");
    bf16x8 idf[2]; make_idf(idf, lane);
    const LAS unsigned char* rd = ring + lane * 16;
    asm volatile("s_waitcnt vmcnt(0)" ::: "memory");
    __builtin_amdgcn_s_barrier();
#pragma unroll
    for (int jj = 0; jj < 4; ++jj) { const int j = wave + 8 * jj, kt = j >> 2, vt = j & 3;
        LAS unsigned char* fp = ring + kt * 16384 + (8 + 2 * vt) * 1024 + lane * 16;
        f32x16 vc = MFMA32(*(const LAS bf16x8*)(fp), idf[0], zero16()); vc = MFMA32(*(const LAS bf16x8*)(fp + 1024), idf[1], vc);
        bf16x8 a0, a1; acc2frag(vc, a0, a1); *(LAS bf16x8*)(fp) = a0; *(LAS bf16x8*)(fp + 1024) = a1; }
    asm volatile("s_waitcnt lgkmcnt(0)" ::: "memory");
    __builtin_amdgcn_s_barrier();
    const float c1 = 0.08838834764831845f * LOG2E;
    for (int i2 = 0; i2 < 2; ++i2) {
        const int qb = part * 16 + i2 * 8 + wave;
        const bf16* qrow = QXA + ((size_t)b * SEQ + qb * 32 + tl) * DXA + hd * 128 + 8 * h;
        bf16x8 qf[8];
#pragma unroll
        for (int q = 0; q < 8; ++q) qf[q] = ldf(qrow + 16 * q);
        f32x16 O[4];
#pragma unroll
        for (int vt = 0; vt < 4; ++vt) O[vt] = zero16();
        float mr = 0.f, lr = 0.f, off = 0.f;
        for (int kt = 0; kt < NMEM / 32; ++kt) {
            const LAS unsigned char* kp = rd + kt * 16384;
            f32x16 s = MFMA32(*(const LAS bf16x8*)(kp), qf[0], zero16());
#pragma unroll
            for (int q = 1; q < 8; ++q) s = MFMA32(*(const LAS bf16x8*)(kp + q * 1024), qf[q], s);
            float x[16];
#pragma unroll
            for (int i = 0; i < 16; ++i) x[i] = s[i] * c1 + off;
            bf16x8 pf0, pf1; SOFTMAX_LAZY(x, off, mr, lr, O, 4, pf0, pf1);
#pragma unroll
            for (int vt = 0; vt < 4; ++vt) { O[vt] = MFMA32(*(const LAS bf16x8*)(kp + (8 + 2 * vt) * 1024), pf0, O[vt]); O[vt] = MFMA32(*(const LAS bf16x8*)(kp + (9 + 2 * vt) * 1024), pf1, O[vt]); }
        }
        lr += __shfl_xor(lr, 32);
        const float il = 1.0f / lr;
        bf16* orow = OXA + ((size_t)b * SEQ + qb * 32 + tl) * DXA + hd * 128;
#pragma unroll
        for (int vt = 0; vt < 4; ++vt)
#pragma unroll
            for (int k = 0; k < 4; k += 2) { v2u w[2];
#pragma unroll
                for (int e = 0; e < 2; ++e) { w[e].x = cvtpk(O[vt][4 * (k + e)] * il, O[vt][4 * (k + e) + 1] * il); w[e].y = cvtpk(O[vt][4 * (k + e) + 2] * il, O[vt][4 * (k + e) + 3] * il); }
                store_pair16(orow + 32 * vt, h, k, w[0], w[1]); }
    }
}

__device__ __forceinline__ size_t gla_frag_off(int b, int hd, int c, int R, int q, int lane) { return ((((((size_t)b * 4 + hd) * 32 + c) * 2 + R) * 4 + q) * 64 + lane) * 8; }
__device__ __forceinline__ void gla_prep_item(const bf16* PROJ, unsigned char* ws, int b, int hd, int c, const float* gate_b, int lane) {
    const int tl = lane & 31, h = lane >> 5;
    bf16* GQD = (bf16*)(ws + WS_GQD); bf16* GKI = (bf16*)(ws + WS_GKI); float* GEB = (float*)(ws + WS_GEB);
    const bf16* cbR[2]; cbR[0] = PROJ + ((size_t)b * SEQ + 64 * c + tl) * NPROJ; cbR[1] = cbR[0] + (size_t)32 * NPROJ;
    const float* gb = gate_b + hd * 64 + 4 * h;
    v2u zl[4][2], zh[4][2], ql[4][2], qh[4][2], kl[4][2], kh[4][2]; f32x4 b0[4], b1[4];
#pragma unroll
    for (int q = 0; q < 4; ++q) { b0[q] = *(const GAS f32x4*)(gb + 16 * q); b1[q] = *(const GAS f32x4*)(gb + 16 * q + 8);
#pragma unroll
        for (int R = 0; R < 2; ++R) { const bf16* rp = cbR[R] + C_Z + hd * 64 + 16 * q + 4 * h; const bf16* rq = cbR[R] + C_GQ + hd * 64 + 16 * q + 4 * h; const bf16* rk = cbR[R] + C_GK + hd * 64 + 16 * q + 4 * h;
            zl[q][R] = *(const GAS v2u*)rp; zh[q][R] = *(const GAS v2u*)(rp + 8); ql[q][R] = *(const GAS v2u*)rq; qh[q][R] = *(const GAS v2u*)(rq + 8); kl[q][R] = *(const GAS v2u*)rk; kh[q][R] = *(const GAS v2u*)(rk + 8); } }
#pragma unroll
    for (int q = 0; q < 4; ++q) {
        float bc[2][8];
        const float bias[8] = {b0[q].x, b0[q].y, b0[q].z, b0[q].w, b1[q].x, b1[q].y, b1[q].z, b1[q].w};
#pragma unroll
        for (int R = 0; R < 2; ++R) {
            const v2u lo = zl[q][R], hi = zh[q][R];
            const float z[8] = {bflo(lo.x), bfhi(lo.x), bflo(lo.y), bfhi(lo.y), bflo(hi.x), bfhi(hi.x), bflo(hi.y), bfhi(hi.y)};
#pragma unroll
            for (int j = 0; j < 8; ++j) { const float zz = z[j] + bias[j];
                bc[R][j] = (fminf(zz, 0.f) * LOG2E - __builtin_amdgcn_logf(1.0f + __builtin_amdgcn_exp2f(-fabsf(zz) * LOG2E))) * (1.f / 16.f); }
        }
#pragma unroll
        for (int dl = 1; dl < 32; dl <<= 1)
#pragma unroll
            for (int R = 0; R < 2; ++R)
#pragma unroll
                for (int j = 0; j < 8; ++j) { const float t = __shfl_up(bc[R][j], dl, 32); if (tl >= dl) bc[R][j] += t; }
        float eb[8];
#pragma unroll
        for (int j = 0; j < 8; ++j) { bc[1][j] += __shfl(bc[0][j], 31, 32); eb[j] = __builtin_amdgcn_exp2f(__shfl(bc[1][j], 31, 32)); }
        if (tl == 0) { float* e = GEB + ((((size_t)b * 4 + hd) * 32 + c) * 4 + q) * 16 + h * 8;
            *(GAS f32x4*)e = (f32x4){eb[0], eb[1], eb[2], eb[3]}; *(GAS f32x4*)(e + 4) = (f32x4){eb[4], eb[5], eb[6], eb[7]}; }
#pragma unroll
        for (int R = 0; R < 2; ++R) {
            const v2u ql_ = ql[q][R], qh_ = qh[q][R], kl_ = kl[q][R], kh_ = kh[q][R];
            const float qv[8] = {bflo(ql_.x), bfhi(ql_.x), bflo(ql_.y), bfhi(ql_.y), bflo(qh_.x), bfhi(qh_.x), bflo(qh_.y), bfhi(qh_.y)};
            const float kv[8] = {bflo(kl_.x), bfhi(kl_.x), bflo(kl_.y), bfhi(kl_.y), bflo(kh_.x), bfhi(kh_.x), bflo(kh_.y), bfhi(kh_.y)};
            float qq[8], kk[8];
#pragma unroll
            for (int j = 0; j < 8; ++j) { qq[j] = qv[j] * 0.125f * __builtin_amdgcn_exp2f(bc[R][j]); kk[j] = kv[j] * __builtin_amdgcn_exp2f(-bc[R][j]); }
            v4u wq, wk;
            wq.x = cvtpk(qq[0], qq[1]); wq.y = cvtpk(qq[2], qq[3]); wq.z = cvtpk(qq[4], qq[5]); wq.w = cvtpk(qq[6], qq[7]);
            wk.x = cvtpk(kk[0], kk[1]); wk.y = cvtpk(kk[2], kk[3]); wk.z = cvtpk(kk[4], kk[5]); wk.w = cvtpk(kk[6], kk[7]);
            const size_t fo = gla_frag_off(b, hd, c, R, q, lane);
            *(GAS v4u*)(GQD + fo) = wq; *(GAS v4u*)(GKI + fo) = wk;
        }
    }
}
__device__ __forceinline__ void gla_fast_item(const bf16* PROJ, const unsigned char* ws, float* OGLA, int b, int hd, int vq, int lane) {
    const int tl = lane & 31, h = lane >> 5;
    const bf16* GQD = (const bf16*)(ws + WS_GQD); const bf16* GKI = (const bf16*)(ws + WS_GKI); const float* GEB = (const float*)(ws + WS_GEB);
    bf16x8 idf[2]; make_idf(idf, lane);
    bf16x8 idp[2];
#pragma unroll
    for (int q = 0; q < 2; ++q)
#pragma unroll
        for (int j = 0; j < 8; ++j) idp[q][j] = ((16 * q + 8 * (j >> 2) + 4 * h + (j & 3)) == tl) ? (short)0x3F80 : (short)0;
    f32x16 S[2]; S[0] = zero16(); S[1] = zero16();
    const bf16* vbase = (const bf16*)(ws + WS_GVF) + gvf_off(b, hd, 0, vq, 0) + lane * 8;
    for (int c = 0; c < SEQ / 64; ++c) {
        bf16x8 qd[2][4], ki[2][4];
        { const GAS bf16* fq_ = (const GAS bf16*)(GQD + gla_frag_off(b, hd, c, 0, 0, lane)); const GAS bf16* fk_ = (const GAS bf16*)(GKI + gla_frag_off(b, hd, c, 0, 0, lane));
          asm volatile("" : "+v"(fq_), "+v"(fk_));
#pragma unroll
          for (int R = 0; R < 2; ++R)
#pragma unroll
              for (int q = 0; q < 4; ++q) { qd[R][q] = *(const GAS bf16x8*)(fq_ + (R * 4 + q) * 512); ki[R][q] = *(const GAS bf16x8*)(fk_ + (R * 4 + q) * 512); } }
        f32x16 o[2]; o[0] = zero16(); o[1] = zero16();
#pragma unroll
        for (int dt = 0; dt < 2; ++dt) { bf16x8 sb0, sb1; acc2frag(S[dt], sb0, sb1);
#pragma unroll
            for (int tt = 0; tt < 2; ++tt) { o[tt] = MFMA32(qd[tt][2 * dt], sb0, o[tt]); o[tt] = MFMA32(qd[tt][2 * dt + 1], sb1, o[tt]); } }
        bf16x8 vb[2][2];
#pragma unroll
        for (int ts = 0; ts < 2; ++ts) { const bf16* vp = vbase + (size_t)(2 * c + ts) * 4096;
            f32x16 vc = MFMA32(ldf(vp), idf[0], zero16()); vc = MFMA32(ldf(vp + 512), idf[1], vc); acc2frag(vc, vb[ts][0], vb[ts][1]); }
#pragma unroll
        for (int ts = 0; ts < 2; ++ts)
#pragma unroll
            for (int tt = ts; tt < 2; ++tt) {
                f32x16 at = MFMA32(ki[ts][0], qd[tt][0], zero16());
#pragma unroll
                for (int q = 1; q < 4; ++q) at = MFMA32(ki[ts][q], qd[tt][q], at);
                if (ts == tt) {
#pragma unroll
                    for (int i = 0; i < 16; ++i) if (SROW(i, h) > tl) at[i] = 0.f;
                }
                bf16x8 x0, x1; acc2frag(at, x0, x1);
                o[tt] = MFMA32(x0, vb[ts][0], o[tt]); o[tt] = MFMA32(x1, vb[ts][1], o[tt]);
            }
        const float* ebp = GEB + (((size_t)b * 4 + hd) * 32 + c) * 64 + h * 8;
#pragma unroll
        for (int dt = 0; dt < 2; ++dt) {
#pragma unroll
            for (int ts = 0; ts < 2; ++ts) { f32x16 kc = MFMA32(ki[ts][2 * dt], idp[0], zero16()); kc = MFMA32(ki[ts][2 * dt + 1], idp[1], kc);
                bf16x8 ka0, ka1; acc2frag(kc, ka0, ka1); S[dt] = MFMA32(ka0, vb[ts][0], S[dt]); S[dt] = MFMA32(ka1, vb[ts][1], S[dt]); }
#pragma unroll
            for (int g2 = 0; g2 < 2; ++g2) { const f32x4 e0 = *(const GAS f32x4*)(ebp + (2 * dt + g2) * 16), e1 = *(const GAS f32x4*)(ebp + (2 * dt + g2) * 16 + 4);
                S[dt][8 * g2 + 0] *= e0.x; S[dt][8 * g2 + 1] *= e0.y; S[dt][8 * g2 + 2] *= e0.z; S[dt][8 * g2 + 3] *= e0.w;
                S[dt][8 * g2 + 4] *= e1.x; S[dt][8 * g2 + 5] *= e1.y; S[dt][8 * g2 + 6] *= e1.z; S[dt][8 * g2 + 7] *= e1.w; }
        }
#pragma unroll
        for (int tt = 0; tt < 2; ++tt)
#pragma unroll
            for (int i = 0; i < 16; ++i) OGLA[((size_t)b * SEQ + 64 * c + 32 * tt + SROW(i, h)) * 512 + hd * 128 + 32 * vq + tl] = o[tt][i];
    }
}

constexpr int CW_QW = 32768;
__device__ __forceinline__ void mix_wg_phase(LAS unsigned char* lds, unsigned char* ws, int qslot, int layer, int lane, int wave, int bx, int G, int parts = 7) {
    const bf16* PROJ = (const bf16*)(ws + WS_PROJ); bf16* MIX = (bf16*)(ws + WS_XN); float* OGLA = (float*)(ws + WS_OGLA); const float* PA = (const float*)(ws + WS_PAR);
    if (parts & 1) for (int idx = bx * NWAVES + wave; idx < NB * 16; idx += G * NWAVES) { int ln = lane; asm volatile("" : "+v"(ln)); gla_fast_item(PROJ, ws, OGLA, idx >> 4, (idx >> 2) & 3, idx & 3, ln); }
    asm volatile("" ::: "memory");
    const float li = 0.8f - 0.6f * expf(-0.3f * (float)layer);
    float lam_full;
    { int ln = lane; asm volatile("" : "+v"(ln));
      const float* lam = PA + PA_LAM + layer * 128;
      const float pa = lam[ln], pb = lam[64 + ln];
      const float s1 = 0.5f * wave_sum(pa * __shfl_xor(pa, 32)), s2 = 0.5f * wave_sum(pb * __shfl_xor(pb, 32));
      lam_full = __int_as_float(__builtin_amdgcn_readfirstlane(__float_as_int(expf(s1) - expf(s2) + li))); }
    if (parts & 4) for (int it = bx; it < NB * 16; it += G) {
        __builtin_amdgcn_s_barrier();
        int ln = lane; asm volatile("" : "+v"(ln));
        const int g = (it >> 3) & 1;
        swa_wg_item(lds + RING_OFF, PROJ, (const bf16*)(ws + WS_SKV), MIX, it >> 4, g, (it & 7) * 8, PA[PA_SINK + layer * 16 + g * 8 + wave], ln, wave);
    }
    volatile LAS unsigned* bc = (volatile LAS unsigned*)(lds + MISC_OFF) + 16;
    unsigned* headw = (unsigned*)(ws + WS_CTL) + CW_QW + 64 * qslot;
    if (parts & 2) for (;;) {
        __builtin_amdgcn_s_barrier();
        if (wave == 0 && lane == 0) bc[0] = __hip_atomic_fetch_add(headw, 1u, __ATOMIC_RELAXED, __HIP_MEMORY_SCOPE_AGENT);
        asm volatile("s_waitcnt vmcnt(0) lgkmcnt(0)" ::: "memory");
        __builtin_amdgcn_s_barrier();
        const int it = __builtin_amdgcn_readfirstlane((int)bc[0]);
        if (it >= NB * 8 * 8) break;
        int ln = lane; asm volatile("" : "+v"(ln));
        const int pair = it & 127;
        diff_wg_item(lds + RING_OFF, PROJ, (const bf16*)(ws + WS_DKV), MIX, pair >> 3, pair & 7, 7 - (it >> 7), lam_full, 1.0f - li, PA + PA_SUB + layer * 64, ln, wave);
    }
}


#ifndef REP_MIX
#define REP_MIX 1
#endif
#ifndef PROBE_MIX_PART
#define PROBE_MIX_PART 0
#endif
#ifndef PROBE_PHASE
#define PROBE_PHASE -1
#define PROBE_REPS 0
#endif
#ifndef REP_NORM
#define REP_NORM 1
#endif
enum { L_PROJ = 0, L_GPREP, L_MIX, L_MIX2, L_OUT, L_XQ, L_XATT, L_XO, L_HALO, L_UP, L_DOWN, PH_PER_LAYER };
constexpr int PH_L0 = 2, PH_FINAL = PH_L0 + NLAYER * PH_PER_LAYER, NPHASE = PH_FINAL + 1;
struct Args { const float* in[22]; float* out; unsigned char* ws; int ph_lo, ph_hi; };
static_assert(sizeof(Args) == 200, "Args has no padding bytes");

__device__ __forceinline__ bool ph_in(int lo, int hi, int k) { asm volatile("" : "+s"(lo), "+s"(hi)); return lo <= k && k < hi; }
__device__ __forceinline__ bool ph_seam(int hi, int k) { asm volatile("" : "+s"(hi)); return k + 1 < hi; }
#define IN(k) ph_in(lo, hi, (k))
#define SEAM(k) do { if (ph_seam(hi, (k))) xcd_barrier(bar); } while (0)
#define PHASE_ENV() GAS unsigned char* wsg_ = (GAS unsigned char*)ws0; GAS float* outg_ = (GAS float*)out0; int tid_ = threadIdx.x, G = gridDim.x, bx = blockIdx.x; \
    asm volatile("" : "+s"(wsg_), "+s"(outg_), "+v"(tid_), "+s"(G), "+s"(bx)); \
    const int lane = tid_ & 63, wave = __builtin_amdgcn_readfirstlane(tid_ >> 6), gw = wave * G + bx, ngw = G * NWAVES;     \
    unsigned char* const ws = (unsigned char*)wsg_; float* const out = (float*)outg_; \
    bf16* const HB = (bf16*)(ws + WS_HB); bf16* const MIX = (bf16*)(ws + WS_XN); float* const SSQ = (float*)(ws + WS_SSQ); bf16* const PROJ = (bf16*)(ws + WS_PROJ); bf16* const ACT = PROJ; \
    bf16* const QXA = (bf16*)(ws + WS_QXA); bf16* const OXA = (bf16*)(ws + WS_OXA); bf16* const XH = (bf16*)(ws + WS_XH); float* const HALO = (float*)(ws + WS_HALO); \
    bf16* const KVMEM = (bf16*)(ws + WS_KVMEM); const float* const PA = (const float*)(ws + WS_PAR); \
    (void)HB; (void)SSQ; (void)MIX; (void)PROJ; (void)ACT; (void)QXA; (void)OXA; (void)XH; (void)HALO; (void)KVMEM; (void)PA; (void)out; (void)lane; (void)wave; (void)gw; (void)ngw; (void)G; (void)bx
#define LAYER_ENV() PHASE_ENV(); constexpr int l = L0

template <int L0>
__device__ __forceinline__ void layer_phases(LAS unsigned char* lds, const XcdBarrier bar, const int lo, const int hi, unsigned char* const ws0, float* const out0, const float* const xin) {
    constexpr int pb = PH_L0 + L0 * PH_PER_LAYER;
        if (IN(pb + L_PROJ)) { LAYER_ENV();
            pg8::Gemm g{HB, wlp(ws, l, WO_IN), T, NPROJ, D}; pg8::StaticOrder S; S.init(T, NPROJ, G, bx);
            pg8::EpiProj E{PROJ, NPROJ, SSQ, (bf16*)(ws + WS_DKV), (bf16*)(ws + WS_SKV), (bf16*)(ws + WS_GVF)};
            pg8::gemm_phase<pg8::EpiProj, pg8::StaticOrder, PG8_ALIGN, PG8_SP2>(lds + RING_OFF, g, S, E);
            SEAM(pb + L_PROJ);
        }
        if (IN(pb + L_GPREP)) { LAYER_ENV();
            for (int it = gw; it < NB * 4 * 32; it += ngw) { int ln = lane; asm volatile("" : "+v"(ln)); gla_prep_item(PROJ, ws, it >> 7, (it >> 5) & 3, it & 31, PA + PA_GB + l * 256, ln); }
            SEAM(pb + L_GPREP);
        }
        if (IN(pb + L_MIX)) { LAYER_ENV(); for (int rep = 0; rep < REP_MIX; ++rep) mix_wg_phase(lds, ws, l + 4 * rep, l, lane, wave, bx, G);
#if PROBE_MIX_PART != 0
            mix_wg_phase(lds, ws, l + 8, l, lane, wave, bx, G, PROBE_MIX_PART);
#endif
            SEAM(pb + L_MIX); }
        if (IN(pb + L_MIX2)) { LAYER_ENV();
            for (int rep = 0; rep < REP_MIX; ++rep) for (int r = gw; r < T; r += 2 * ngw) { const int r1 = r + ngw;
                if (r1 < T) gla_finish_row2(PROJ, (const float*)(ws + WS_OGLA), MIX, PA + PA_GNG + l * 128, r, r1, lane);
                else gla_finish_row(PROJ, (const float*)(ws + WS_OGLA), MIX, PA + PA_GNG + l * 128, r, lane); }
            SEAM(pb + L_MIX2);
        }
        if (IN(pb + L_OUT)) { LAYER_ENV();
            pg8::Gemm g{MIX, wlp(ws, l, WO_OUT), T, D, D}; pg8::StaticOrder S; S.init(T, D, G, bx);
            pg8::EpiResNorm E{HB, SSQ, nullptr, lds + XCH_OFF, D};
            pg8::gemm_phase<pg8::EpiResNorm, pg8::StaticOrder, true, PG8_SP2>(lds + RING_OFF, g, S, E);
            SEAM(pb + L_OUT);
        }
        if (IN(pb + L_XQ)) { LAYER_ENV();
            pg8::Gemm g{HB, wlp(ws, l, WO_XQ), T, DXA, D}; pg8::StaticOrder S; S.init(T, DXA, G, bx);
            pg8::EpiBf16S E{QXA, DXA, SSQ};
            pg8::gemm_phase<pg8::EpiBf16S, pg8::StaticOrder, PG8_ALIGN, PG8_SP2>(lds + RING_OFF, g, S, E);
            SEAM(pb + L_XQ);
        }
        if (IN(pb + L_XATT)) { LAYER_ENV();
            for (int rep = 0; rep < REP_MIX; ++rep) for (int it = bx; it < NB * 4 * 4; it += G) { int ln = lane; asm volatile("" : "+v"(ln));
                __builtin_amdgcn_s_barrier();
                xatt_wg_item(lds + RING_OFF, QXA, KVMEM, OXA, l, it >> 4, (it >> 2) & 3, it & 3, ln, wave); }
            SEAM(pb + L_XATT);
        }
        if (IN(pb + L_XO)) { LAYER_ENV();
            pg8::Gemm g{OXA, wlp(ws, l, WO_XO), T, D, DXA}; pg8::StaticOrder S; S.init(T, D, G, bx);
            pg8::EpiResNorm E{HB, SSQ, XH, lds + XCH_OFF, D};
            pg8::gemm_phase<pg8::EpiResNorm, pg8::StaticOrder, true, PG8_SP2>(lds + RING_OFF, g, S, E);
            SEAM(pb + L_XO);
        }
        if (IN(pb + L_HALO)) { LAYER_ENV();
            pg8::Gemm g{XH, wlp(ws, l, WO_UP), 256, NUP, D}; pg8::StaticOrder S; S.init(256, NUP, G, bx);
            pg8::EpiF32 E{HALO, NUP, SSQ};
            pg8::gemm_phase<pg8::EpiF32, pg8::StaticOrder, PG8_ALIGN, PG8_SP2>(lds + RING_OFF, g, S, E);
            if (bx >= 44) { float* RSTD = (float*)(ws + WS_RSTD);
                for (int r = (bx - 44) * (NWAVES * 64) + tid_; r < T; r += (G - 44) * (NWAVES * 64)) RSTD[r] = pg8::row_rstd(SSQ, r);
                if (l + 1 < NLAYER) {
                    const unsigned long long* pp = (const unsigned long long*)(ws + WS_PAR + PA_PTRS * 4);
                    const WSrc W{(const float*)(const GAS float*)pp[0], (const float*)(const GAS float*)pp[1], (const float*)(const GAS float*)pp[2], (const float*)(const GAS float*)pp[3],
                                 (const float*)(const GAS float*)pp[4], (const float*)(const GAS float*)pp[5], PA + PA_NMIX, PA + PA_NXA, PA + PA_NFFN};
                    LAS float* scr = (LAS float*)(lds + RING_OFF + wave * 16384);
                    for (int it = (bx - 44) + wave * (G - 44); it < TI_LAYER_NOKV; it += (G - 44) * NWAVES) convert_layer_item(W, ws, l + 1, it, scr, lane);
                } }
            SEAM(pb + L_HALO);
        }
        if (IN(pb + L_UP)) { LAYER_ENV();
            pg8::Gemm g{HB, wlp(ws, l, WO_UP), T, NUP, D}; pg8::StaticOrder S; S.init(T, NUP, G, bx);
            pg8::EpiConvGlu E{ACT, PA + PA_CW + l * 3 * NUP, PA + PA_CB + l * NUP, HALO, (const float*)(ws + WS_RSTD), lds + XCH_OFF, DFF, NUP};
            pg8::gemm_phase<pg8::EpiConvGlu, pg8::StaticOrder, true, PG8_SP2>(lds + RING_OFF, g, S, E);
            SEAM(pb + L_UP);
        }
        if (IN(pb + L_DOWN)) { LAYER_ENV();
            pg8::Gemm g{ACT, wlp(ws, l, WO_DN), T, D, DFF}; pg8::StaticOrder S; S.init(T, D, G, bx);
            pg8::EpiResNorm E{HB, SSQ, nullptr, lds + XCH_OFF, D};
            pg8::gemm_phase<pg8::EpiResNorm, pg8::StaticOrder, true, PG8_SP2>(lds + RING_OFF, g, S, E);
            SEAM(pb + L_DOWN);
        }
}

__global__ void __launch_bounds__(NWAVES * 64, 2) trunk_fwd(Args args) {
    extern __shared__ __attribute__((aligned(16))) unsigned char lds_raw[];
    LAS unsigned char* lds = (LAS unsigned char*)lds_raw;
    volatile LAS unsigned* MISC = (volatile LAS unsigned*)(lds + MISC_OFF);
    const int tid = threadIdx.x;
    unsigned char* const ws0 = args.ws; float* const out0 = args.out;
    const int lo = args.ph_lo, hi = args.ph_hi;
    for (int u = tid; u < (LDS_BYTES - MISC_OFF) / 4; u += NWAVES * 64) ((LAS unsigned*)(lds + MISC_OFF))[u] = 0u;
    __syncthreads();
    XcdBarrier bar; bar.bar = (unsigned*)(ws0 + WS_CTL) + CW_BAR; bar.x = 0; bar.st = nullptr;
    if (hi - lo > 1) bar = xcd_barrier_post((unsigned*)(ws0 + WS_CTL) + CW_BAR, MISC + 8);
    if (IN(0)) { PHASE_ENV(); Ptrs PP;
#pragma unroll
        for (int i = 0; i < 22; ++i) PP.in[i] = args.in[i];
        PP.out = out; PP.ws = ws;
        prologue_phase(PP, lds, gw, ngw, wave, lane); SEAM(0); }
    if (IN(1)) { PHASE_ENV();
        pg8::Gemm g{(const bf16*)(ws + WS_MEMN), (const bf16*)(ws + WS_WKV), MROWS, 4096, D}; pg8::StaticOrder S; S.init(MROWS, 4096, G, bx);
        pg8::EpiKvFrag E{KVMEM};
        pg8::gemm_phase<pg8::EpiKvFrag, pg8::StaticOrder, PG8_ALIGN, PG8_SP2>(lds + RING_OFF, g, S, E);
    }
    layer_phases<0>(lds, bar, lo, hi, ws0, out0, args.in[0]);
    layer_phases<1>(lds, bar, lo, hi, ws0, out0, args.in[0]);
    layer_phases<2>(lds, bar, lo, hi, ws0, out0, args.in[0]);
    layer_phases<3>(lds, bar, lo, hi, ws0, out0, args.in[0]);
    if (IN(PH_FINAL)) { PHASE_ENV();
        for (int r = gw; r < T; r += 2 * ngw) { const int r1 = r + ngw;
            if (r1 < T) rms_row_final2(HB + (size_t)r * D, HB + (size_t)r1 * D, out + (size_t)r * D, out + (size_t)r1 * D, PA + PA_FIN, SSQ + (size_t)r * 8, SSQ + (size_t)r1 * 8, lane);
            else rms_row_final(HB + (size_t)r * D, out + (size_t)r * D, PA + PA_FIN, SSQ + (size_t)r * 8, lane); }
    }
#undef IN
#undef SEAM
}

extern "C" void kernel_launch(void* const* d_in, const int* in_sizes, int n_in, void* d_out, int out_size, void* d_ws, size_t ws_size, hipStream_t stream) {
    static int grid = 0;
    if (grid == 0) {
        if (n_in != 22 || in_sizes[0] != T * D || out_size != T * D || ws_size < WS_END) { fprintf(stderr, "kernel_launch: unexpected problem (n_in %d, in0 %d, out %d, ws %zu < %zu); nothing launched\n", n_in, n_in > 0 ? in_sizes[0] : -1, out_size, ws_size, (size_t)WS_END); grid = -1; return; }
        int dev = 0, cus = 0, per_cu = 0;
        if (hipGetDevice(&dev) != hipSuccess || hipDeviceGetAttribute(&cus, hipDeviceAttributeMultiprocessorCount, dev) != hipSuccess) { grid = -1; return; }
        if (hipFuncSetAttribute((const void*)trunk_fwd, hipFuncAttributeMaxDynamicSharedMemorySize, LDS_BYTES) != hipSuccess) { fprintf(stderr, "kernel_launch: hipFuncSetAttribute failed\n"); grid = -1; return; }
        if (hipOccupancyMaxActiveBlocksPerMultiprocessor(&per_cu, (const void*)trunk_fwd, NWAVES * 64, LDS_BYTES) != hipSuccess || per_cu < 1) fprintf(stderr, "kernel_launch: occupancy query reports %d workgroups per CU\n", per_cu);
        (void)hipGetLastError();
        grid = cus;
    }
    if (grid < 0) return;
    (void)hipMemsetAsync((char*)d_ws + WS_CTL, 0, CTL_ZERO_BYTES, stream);
    Args a{};
    for (int i = 0; i < 22; ++i) a.in[i] = (const float*)d_in[i];
    a.out = (float*)d_out; a.ws = (unsigned char*)d_ws;
#if MK_ONE_LAUNCH
    a.ph_lo = 0; a.ph_hi = NPHASE;
    hipLaunchKernelGGL(trunk_fwd, dim3(grid), dim3(NWAVES * 64), LDS_BYTES, stream, a);
#else
    for (int p = 0; p < NPHASE; ++p) { a.ph_lo = p; a.ph_hi = p + 1;
        const int reps = 1 + (p == PROBE_PHASE ? PROBE_REPS : 0);
        for (int rep = 0; rep < reps; ++rep) hipLaunchKernelGGL(trunk_fwd, dim3(grid), dim3(NWAVES * 64), LDS_BYTES, stream, a); }
#endif
}
```
